# Optimizing an MI355X kernel written in HIP

```python
import jax, jax.numpy as jnp
from jax import lax
import numpy as np

D_MODEL = 1024
BATCH = 16
SEQ = 4096
DEPTH = 4

HEAD_DIM = 64
N_Q_A = 16
N_KV_A = 2
GROUP_A = N_Q_A // N_KV_A
WINDOW = 128
BLOCK = 128
N_H_B = 16
ROT_DIM = HEAD_DIM // 4
ROPE_THETA = 500000.0
D_FF = -(-8 * D_MODEL // (3 * 256)) * 256
N_MIXERS = 2
N_A = (DEPTH + 1) // 2
N_B = DEPTH // 2
QKV_A = (N_Q_A + 2 * N_KV_A) * HEAD_DIM
QKV_B = 3 * N_H_B * HEAD_DIM
EPS = 1e-6

kernel_name = 'hybrid_swa_sink_stickbreak_block'


def rmsnorm(x, gain):
    xf = x.astype(jnp.float32)
    y = xf * lax.rsqrt(jnp.mean(xf * xf, axis=-1, keepdims=True) + EPS)
    return (y * gain.astype(jnp.float32)).astype(x.dtype)


def partial_rope(x, positions):
    half = ROT_DIM // 2
    inv_freq = jnp.power(jnp.float32(ROPE_THETA), -jnp.arange(half, dtype=jnp.float32) * 2.0 / ROT_DIM)
    ang = positions.astype(jnp.float32)[:, :, None, None] * inv_freq
    cos, sin = jnp.cos(ang), jnp.sin(ang)
    xr = x[..., :ROT_DIM].astype(jnp.float32)
    x1, x2 = xr[..., :half], xr[..., half:]
    rot = jnp.concatenate([x1 * cos - x2 * sin, x2 * cos + x1 * sin], axis=-1).astype(x.dtype)
    return jnp.concatenate([rot, x[..., ROT_DIM:]], axis=-1)


def sliding_window_sink_attention(h, positions, w_qkv, q_gain, k_gain, sinks, w_o):
    B, S, _ = h.shape
    qkv = h @ w_qkv
    q, k, v = jnp.split(qkv, [N_Q_A * HEAD_DIM, (N_Q_A + N_KV_A) * HEAD_DIM], axis=-1)
    q = q.reshape(B, S, N_Q_A, HEAD_DIM)
    k = k.reshape(B, S, N_KV_A, HEAD_DIM)
    v = v.reshape(B, S, N_KV_A, HEAD_DIM)
    q = partial_rope(rmsnorm(q, q_gain), positions)
    k = partial_rope(rmsnorm(k, k_gain), positions)
    q = q.reshape(B, S, N_KV_A, GROUP_A, HEAD_DIM)
    pad = jnp.zeros((B, BLOCK, N_KV_A, HEAD_DIM), k.dtype)
    kp = jnp.concatenate([pad, k], axis=1)
    vp = jnp.concatenate([pad, v], axis=1)
    scale = HEAD_DIM ** -0.5
    q_idx = jnp.arange(BLOCK)[:, None] + BLOCK
    k_idx = jnp.arange(2 * BLOCK)[None, :]
    rel = q_idx - k_idx
    band = (rel >= 0) & (rel < WINDOW)
    sink_logit = sinks.astype(jnp.float32).reshape(1, N_KV_A, GROUP_A, 1, 1)

    def block_fn(i):
        start = i * BLOCK
        qb = lax.dynamic_slice_in_dim(q, start, BLOCK, axis=1)
        kb = lax.dynamic_slice_in_dim(kp, start, 2 * BLOCK, axis=1)
        vb = lax.dynamic_slice_in_dim(vp, start, 2 * BLOCK, axis=1)
        s = jnp.einsum('bqkgd,bskd->bkgqs', qb, kb).astype(jnp.float32) * scale
        valid = band & (start - BLOCK + k_idx >= 0)
        s = jnp.where(valid, s, -jnp.inf)
        sink_col = jnp.broadcast_to(sink_logit, s.shape[:-1] + (1,))
        p = jax.nn.softmax(jnp.concatenate([s, sink_col], axis=-1), axis=-1)[..., :-1]
        o = jnp.einsum('bkgqs,bskd->bqkgd', p.astype(vb.dtype), vb)
        return o.reshape(B, BLOCK, N_Q_A * HEAD_DIM)

    out = lax.map(block_fn, jnp.arange(S // BLOCK))
    out = jnp.moveaxis(out, 0, 1).reshape(B, S, N_Q_A * HEAD_DIM)
    return out @ w_o


def stick_breaking_attention(h, w_qkv, w_o):
    B, S, _ = h.shape
    qkv = h @ w_qkv
    q, k, v = jnp.split(qkv, 3, axis=-1)
    q = q.reshape(B, S, N_H_B, HEAD_DIM)
    k = k.reshape(B, S, N_H_B, HEAD_DIM)
    v = v.reshape(B, S, N_H_B, HEAD_DIM)
    scale = HEAD_DIM ** -0.5
    k_idx = jnp.arange(S)[None, :]

    def block_fn(i):
        start = i * BLOCK
        qb = lax.dynamic_slice_in_dim(q, start, BLOCK, axis=1)
        z = jnp.einsum('bqhd,bshd->bhqs', qb, k).astype(jnp.float32) * scale
        t_idx = start + jnp.arange(BLOCK)[:, None]
        strict = k_idx < t_idx
        log_beta = jax.nn.log_sigmoid(z)
        log_one_minus = jnp.where(strict, jax.nn.log_sigmoid(-z), 0.0)
        rc = lax.cumsum(log_one_minus, axis=3, reverse=True)
        after = jnp.pad(rc[..., 1:], ((0, 0), (0, 0), (0, 0), (0, 1)))
        a = jnp.where(strict, jnp.exp(log_beta + after), 0.0)
        o = jnp.einsum('bhqs,bshd->bqhd', a.astype(v.dtype), v)
        return o.reshape(B, BLOCK, N_H_B * HEAD_DIM)

    out = lax.map(block_fn, jnp.arange(S // BLOCK))
    out = jnp.moveaxis(out, 0, 1).reshape(B, S, N_H_B * HEAD_DIM)
    return out @ w_o


def swiglu(h, w_gate, w_up, w_down):
    return (jax.nn.silu(h @ w_gate) * (h @ w_up)) @ w_down


def setup_inputs(seed: int = 0) -> dict:
    key = jax.random.key(seed)
    ks = jax.random.split(key, 20)
    f32 = jnp.float32
    nrm = lambda k, shape, s: jax.random.normal(k, shape, f32) * s
    x = jax.random.normal(ks[0], (BATCH, SEQ, D_MODEL), f32)
    c = jax.random.normal(ks[1], (BATCH, D_MODEL), f32)
    offset = jax.random.randint(ks[2], (BATCH, 1), 0, 4096, dtype=jnp.int32)
    positions = offset + jnp.arange(SEQ, dtype=jnp.int32)[None, :]
    return {
        'x': x,
        'c': c,
        'positions': positions,
        'ada_w': nrm(ks[3], (DEPTH, D_MODEL, 6 * D_MODEL), 0.5 * D_MODEL ** -0.5),
        'ada_b': nrm(ks[4], (DEPTH, 6 * D_MODEL), 0.01),
        'norm1_g': 1.0 + nrm(ks[5], (DEPTH, D_MODEL), 0.05),
        'norm2_g': 1.0 + nrm(ks[6], (DEPTH, D_MODEL), 0.05),
        'wqkv_a': nrm(ks[7], (N_A, D_MODEL, QKV_A), D_MODEL ** -0.5),
        'q_norm_a': 1.0 + nrm(ks[8], (N_A, HEAD_DIM), 0.05),
        'k_norm_a': 1.0 + nrm(ks[9], (N_A, HEAD_DIM), 0.05),
        'sinks_a': nrm(ks[10], (N_A, N_Q_A), 1.0),
        'wo_a': nrm(ks[11], (N_A, N_Q_A * HEAD_DIM, D_MODEL), (N_Q_A * HEAD_DIM) ** -0.5),
        'wqkv_b': nrm(ks[12], (N_B, D_MODEL, QKV_B), D_MODEL ** -0.5),
        'wo_b': nrm(ks[13], (N_B, N_H_B * HEAD_DIM, D_MODEL), (N_H_B * HEAD_DIM) ** -0.5),
        'w_gate': nrm(ks[14], (DEPTH, D_MODEL, D_FF), D_MODEL ** -0.5),
        'w_up': nrm(ks[15], (DEPTH, D_MODEL, D_FF), D_MODEL ** -0.5),
        'w_down': nrm(ks[16], (DEPTH, D_FF, D_MODEL), D_FF ** -0.5),
    }


def reference(x, c, positions, ada_w, ada_b, norm1_g, norm2_g, wqkv_a, q_norm_a, k_norm_a,
              sinks_a, wo_a, wqkv_b, wo_b, w_gate, w_up, w_down):
    cond = jax.nn.silu(c)
    for i in range(DEPTH):
        mod = (cond @ ada_w[i] + ada_b[i])[:, None, :]
        sh1, sc1, g1, sh2, sc2, g2 = jnp.split(mod, 6, axis=-1)
        h = rmsnorm(x, norm1_g[i]) * (1.0 + sc1) + sh1
        j = i // N_MIXERS
        if i % N_MIXERS == 0:
            y = sliding_window_sink_attention(h, positions, wqkv_a[j], q_norm_a[j], k_norm_a[j],
                                              sinks_a[j], wo_a[j])
        else:
            y = stick_breaking_attention(h, wqkv_b[j], wo_b[j])
        x = x + g1 * y
        h = rmsnorm(x, norm2_g[i]) * (1.0 + sc2) + sh2
        x = x + g2 * swiglu(h, w_gate[i], w_up[i], w_down[i])
    return x
```

```cpp
#include <hip/hip_runtime.h>
#include <hip/hip_cooperative_groups.h>
#include <cstdio>
#include <cstdint>
namespace cg = cooperative_groups;
namespace pg8 {
#define PG8_LAS __attribute__((address_space(3)))
typedef unsigned short bf16_t;
typedef short bf16x8 __attribute__((ext_vector_type(8)));
typedef float f32x4 __attribute__((ext_vector_type(4)));
typedef unsigned u32x4 __attribute__((ext_vector_type(4)));
constexpr int BM = 256, BK = 64, HALF = 128, HTB = HALF * BK * 2  , STAGE_BYTES = 8 * HTB, NXCD = 8, WGM = 8;

__host__ __device__ __forceinline__ int lds_byte(int r, int c) { const int st = (r >> 4) * 2 + (c >> 5), rr = r & 15, cc = c & 31, ob = rr * 64 + cc * 2; return st * 1024 + (ob ^ (((ob >> 9) & 1) << 5)); }
__host__ __device__ __forceinline__ void stage_rc(int b, int& R, int& C) { const int st = b / 1024, sb = b % 1024, swz = sb ^ (((sb >> 9) & 1) << 5); R = (st >> 1) * 16 + swz / 64; C = (st & 1) * 32 + (swz % 64) / 2; }
__host__ __device__ __forceinline__ int perm32(int rho) { const int n = rho >> 4, i = rho & 15; return 8 * (i >> 2) + 4 * n + (i & 3); }

struct Unit { int pm, pn; };
struct Gemm { const bf16_t* A; const bf16_t* Bt; int M, N, K; };

struct StaticOrder {
    int nM, nN, nwg, G, c;
    __host__ __device__ void init(int M, int N, int G_, int c_) { nM = M / BM; nN = N / BM; nwg = nM * nN; G = G_; c = c_; }
    __host__ __device__ bool next(int i, Unit& u) const {
        const long L = (long)i * G + c; if (L >= nwg) return false;
        int wgid = (int)L; { const int q = nwg / NXCD, r = nwg % NXCD, xcd = wgid % NXCD, off = wgid / NXCD; wgid = (xcd < r ? xcd * (q + 1) : r * (q + 1) + (xcd - r) * q) + off; }
        const int nig = WGM * nN, gid = wgid / nig, fm = gid * WGM, gsz = (nM - fm) < WGM ? (nM - fm) : WGM;
        u.pm = fm + ((wgid % nig) % gsz); u.pn = (wgid % nig) / gsz; return true;
    }
    __device__ __forceinline__ void a_ready(const Unit&) const {}
    __device__ __forceinline__ void done(const Unit&) const {}
};

__device__ __forceinline__ unsigned cvt_pk_bf16(float lo, float hi) { unsigned r; asm volatile("v_cvt_pk_bf16_f32 %0, %1, %2" : "=v"(r) : "v"(lo), "v"(hi)); return r; }
typedef float f32x2 __attribute__((ext_vector_type(2)));
template <class Epi, class Sched, bool ALIGN_EPI = false, bool SP2 = false>
__device__ __forceinline__ void gemm_phase(PG8_LAS unsigned char* lds, const Gemm g, const Sched& S, const Epi& E, const int tid) {
    const int wid = __builtin_amdgcn_readfirstlane(tid >> 6), lane = tid & 63, wr = wid >> 2, wc = wid & 3, fr = lane & 15, fq = lane >> 4;
    const int K = g.K, nt = K / BK;
    unsigned voffA[2], voffB[2];
#pragma unroll
    for (int i = 0; i < 2; ++i) { int R, C; stage_rc(tid * 16 + i * 8192, R, C); const int Rb = Epi::PERM ? ((R & ~31) + perm32(R & 31)) : R;
        voffA[i] = (unsigned)(R * K + C) * 2u; voffB[i] = (unsigned)(Rb * K + C) * 2u; }
    const size_t kstep = (size_t)(BK * 2);
    const size_t hstep = (size_t)HALF * K * 2;
    const size_t tstep = 2 * hstep;
    const unsigned ldsw = (unsigned)wid * 1024u;
    const int aoff = lds_byte(wr * 64 + fr, fq * 8), boff = lds_byte(wc * 32 + fr, fq * 8);
#define PG8_SA(b, h) (((b) * 2 + (h)) * HTB)
#define PG8_SB(b, h) ((4 + (b) * 2 + (h)) * HTB)
#define PG8_STAGE(bufoff, gbase, voff) do { _Pragma("unroll") for (int _i = 0; _i < 2; ++_i) \
        __builtin_amdgcn_global_load_lds((const unsigned*)((const char*)(gbase) + (voff)[_i]), (PG8_LAS unsigned*)(lds + (bufoff) + ldsw + _i * 8192), 16, 0, 0); } while (0)
#define PG8_LDA(dst, b, h) do { _Pragma("unroll") for (int m = 0; m < 4; ++m) _Pragma("unroll") for (int k = 0; k < 2; ++k) dst[m][k] = *(const PG8_LAS bf16x8*)(lds + PG8_SA(b, h) + aoff + m * 2048 + k * 1024); } while (0)
#define PG8_LDB(dst, b, h) do { _Pragma("unroll") for (int n = 0; n < 2; ++n) _Pragma("unroll") for (int k = 0; k < 2; ++k) dst[n][k] = *(const PG8_LAS bf16x8*)(lds + PG8_SB(b, h) + boff + n * 2048 + k * 1024); } while (0)
#define PG8_MMA(ai, bj, At, Bt) do { __builtin_amdgcn_s_setprio(1); _Pragma("unroll") for (int m = 0; m < 4; ++m) _Pragma("unroll") for (int n = 0; n < 2; ++n) _Pragma("unroll") for (int k = 0; k < 2; ++k) \
        acc[ai][bj][m][n] = __builtin_amdgcn_mfma_f32_16x16x32_bf16(Bt[n][k], At[m][k], acc[ai][bj][m][n], 0, 0, 0); __builtin_amdgcn_s_setprio(0); } while (0)
#define PG8_WAIT_V(n) asm volatile("s_waitcnt vmcnt(" #n ")" ::: "memory")
#define PG8_WAIT_L(n) asm volatile("s_waitcnt lgkmcnt(" #n ")" ::: "memory")
#define PG8_BAR __builtin_amdgcn_s_barrier()
#define PG8_SCHED __builtin_amdgcn_sched_barrier(0)
    Unit cur, nxt; int ui = 0;
    if (!S.next(0, cur)) return;
    f32x4 acc[2][2][4][2];
#pragma unroll
    for (int a = 0; a < 2; ++a)
#pragma unroll
        for (int b = 0; b < 2; ++b)
#pragma unroll
            for (int m = 0; m < 4; ++m)
#pragma unroll
                for (int n = 0; n < 2; ++n) acc[a][b][m][n] = (f32x4){0.f, 0.f, 0.f, 0.f};
    bf16x8 At[4][2], B0[2][2], B1[2][2];
    const char* cA = (const char*)g.A + (size_t)cur.pm * tstep; const char* cB = (const char*)g.Bt + (size_t)cur.pn * tstep;
    S.a_ready(cur);
    if constexpr (SP2) {
        PG8_STAGE(PG8_SB(0, 0), cB, voffB); PG8_STAGE(PG8_SB(0, 1), cB + hstep, voffB); PG8_STAGE(PG8_SA(0, 0), cA, voffA); PG8_STAGE(PG8_SA(0, 1), cA + hstep, voffA);
        if (wr == 1) PG8_BAR;
        PG8_WAIT_V(2); PG8_BAR;
        PG8_STAGE(PG8_SB(1, 0), cB + kstep, voffB); PG8_STAGE(PG8_SA(1, 0), cA + kstep, voffA); PG8_STAGE(PG8_SB(1, 1), cB + hstep + kstep, voffB);
        PG8_WAIT_V(6); PG8_BAR;
    } else {
        PG8_STAGE(PG8_SB(0, 0), cB, voffB); PG8_STAGE(PG8_SA(0, 0), cA, voffA); PG8_STAGE(PG8_SB(0, 1), cB + hstep, voffB); PG8_STAGE(PG8_SA(0, 1), cA + hstep, voffA);
        if (wr == 1) PG8_BAR;
        PG8_WAIT_V(4); PG8_BAR;
        PG8_STAGE(PG8_SB(1, 0), cB + kstep, voffB); PG8_STAGE(PG8_SA(1, 0), cA + kstep, voffA); PG8_STAGE(PG8_SB(1, 1), cB + hstep + kstep, voffB);
        PG8_WAIT_V(6); PG8_BAR;
    }
    for (;;) {
        const bool has_next = S.next(ui + 1, nxt);
        const char* nA = has_next ? (const char*)g.A + (size_t)nxt.pm * tstep : cA; const char* nB = has_next ? (const char*)g.Bt + (size_t)nxt.pn * tstep : cB;
        for (int t = 0; t < nt; t += 2) {
            const bool last = (t == nt - 2);
            const char* a1 = cA + (size_t)(t + 1) * kstep;
            const char* a2 = last ? nA : cA + (size_t)(t + 2) * kstep; const char* b2 = last ? nB : cB + (size_t)(t + 2) * kstep;
            const char* a3 = a2 + kstep; const char* b3 = b2 + kstep;
            if (last && has_next) S.a_ready(nxt);
            if constexpr (SP2) {
            PG8_LDB(B0, 0, 0); PG8_LDB(B1, 0, 1); PG8_SCHED; PG8_LDA(At, 0, 0); PG8_STAGE(PG8_SA(1, 1), a1 + hstep, voffA);
            PG8_WAIT_V(8); PG8_WAIT_L(0); PG8_BAR; PG8_MMA(0, 0, At, B0); PG8_MMA(0, 1, At, B1); PG8_BAR; PG8_SCHED;
            PG8_LDA(At, 0, 1); PG8_STAGE(PG8_SB(0, 0), b2, voffB); PG8_STAGE(PG8_SB(0, 1), b2 + hstep, voffB); PG8_STAGE(PG8_SA(0, 0), a2, voffA);
            PG8_WAIT_V(8); PG8_WAIT_L(0); PG8_BAR; PG8_MMA(1, 0, At, B0); PG8_MMA(1, 1, At, B1); PG8_BAR; PG8_SCHED;
            PG8_LDB(B0, 1, 0); PG8_LDB(B1, 1, 1); PG8_SCHED; PG8_LDA(At, 1, 0); PG8_STAGE(PG8_SA(0, 1), a2 + hstep, voffA);
            PG8_WAIT_V(8); PG8_WAIT_L(0); PG8_BAR; PG8_MMA(0, 0, At, B0); PG8_MMA(0, 1, At, B1); PG8_BAR; PG8_SCHED;
            PG8_LDA(At, 1, 1); PG8_STAGE(PG8_SB(1, 0), b3, voffB); PG8_STAGE(PG8_SB(1, 1), b3 + hstep, voffB); PG8_STAGE(PG8_SA(1, 0), a3, voffA);
            PG8_WAIT_V(8); PG8_WAIT_L(0); PG8_BAR; PG8_MMA(1, 0, At, B0); PG8_MMA(1, 1, At, B1); PG8_BAR; PG8_SCHED;
            } else {
            PG8_LDB(B0, 0, 0); PG8_SCHED; PG8_LDA(At, 0, 0); PG8_STAGE(PG8_SA(1, 1), a1 + hstep, voffA);
            PG8_WAIT_L(8); PG8_BAR; PG8_WAIT_L(0); PG8_MMA(0, 0, At, B0); PG8_BAR; PG8_SCHED;
            PG8_LDB(B1, 0, 1); PG8_STAGE(PG8_SB(0, 0), b2, voffB);
            PG8_BAR; PG8_WAIT_L(0); PG8_MMA(0, 1, At, B1); PG8_BAR;
            PG8_LDA(At, 0, 1); PG8_STAGE(PG8_SA(0, 0), a2, voffA);
            PG8_BAR; PG8_WAIT_L(0); PG8_MMA(1, 0, At, B0); PG8_BAR; PG8_SCHED;
            PG8_STAGE(PG8_SB(0, 1), b2 + hstep, voffB);
            PG8_WAIT_V(6); PG8_BAR; PG8_MMA(1, 1, At, B1); PG8_BAR;
            PG8_LDB(B0, 1, 0); PG8_SCHED; PG8_LDA(At, 1, 0); PG8_STAGE(PG8_SA(0, 1), a2 + hstep, voffA);
            PG8_WAIT_L(8); PG8_BAR; PG8_WAIT_L(0); PG8_MMA(0, 0, At, B0); PG8_BAR; PG8_SCHED;
            PG8_LDB(B1, 1, 1); PG8_STAGE(PG8_SB(1, 0), b3, voffB);
            PG8_BAR; PG8_WAIT_L(0); PG8_MMA(0, 1, At, B1); PG8_BAR;
            PG8_LDA(At, 1, 1); PG8_STAGE(PG8_SA(1, 0), a3, voffA);
            PG8_BAR; PG8_WAIT_L(0); PG8_MMA(1, 0, At, B0); PG8_BAR; PG8_SCHED;
            PG8_STAGE(PG8_SB(1, 1), b3 + hstep, voffB);
            PG8_WAIT_V(6); PG8_BAR; PG8_MMA(1, 1, At, B1); PG8_BAR;
            }
        }
        if constexpr (ALIGN_EPI) { if (wr == 0) PG8_BAR; }
        if constexpr (!Epi::AFTER_DRAIN) { E(acc, cur, wr, wc, fr, fq); S.done(cur); }
        if (!has_next) break;
#pragma unroll
        for (int a = 0; a < 2; ++a)
#pragma unroll
            for (int b = 0; b < 2; ++b)
#pragma unroll
                for (int m = 0; m < 4; ++m)
#pragma unroll
                    for (int n = 0; n < 2; ++n) acc[a][b][m][n] = (f32x4){0.f, 0.f, 0.f, 0.f};
        cur = nxt; cA = nA; cB = nB; ++ui;
        if constexpr (ALIGN_EPI) { if (wr == 1) PG8_BAR; }
    }
    PG8_WAIT_V(0);
    if constexpr (!ALIGN_EPI) { if (wr == 0) PG8_BAR; }
    PG8_BAR;
    if constexpr (Epi::AFTER_DRAIN) { E.fused(acc, cur, wr, wc, fr, fq, lds, wid, lane); S.done(cur); }
#undef PG8_SA
#undef PG8_SB
#undef PG8_STAGE
#undef PG8_LDA
#undef PG8_LDB
#undef PG8_MMA
#undef PG8_WAIT_V
#undef PG8_WAIT_L
#undef PG8_BAR
#undef PG8_SCHED
}
}

using pg8::bf16_t; using pg8::bf16x8; using pg8::f32x4; using pg8::u32x4; using pg8::cvt_pk_bf16; using pg8::Unit;
typedef float f32x16 __attribute__((ext_vector_type(16)));
typedef unsigned u32x2 __attribute__((ext_vector_type(2)));
#define LAS __attribute__((address_space(3)))

constexpr int DM = 1024, NB = 16, SEQ = 4096, NTOK = NB * SEQ, DEPTH = 4, HD = 64, DFF = 2816, NGU = 2 * DFF;
constexpr int NQKVA = 1280, NQKVB = 3072, NMOD = 6 * DM, SHW1_LD = 3072;
constexpr float EPS = 1e-6f;
constexpr int NPHASE = 2 + 5 * DEPTH;

constexpr size_t MiB = 1u << 20;
constexpr size_t WS_MOD = 0;
constexpr size_t WS_GS = 2 * MiB;
constexpr size_t WS_SHW1 = 3 * MiB;
constexpr size_t WS_SHW3 = 4 * MiB;
constexpr size_t WS_CS = 6 * MiB;
constexpr size_t WS_SSQ = 10 * MiB;
constexpr size_t WS_WQKVA = 16 * MiB;
constexpr size_t WS_WOA = 21 * MiB;
constexpr size_t WS_WQKB = 25 * MiB;
constexpr size_t WS_WVB = 33 * MiB;
constexpr size_t WS_WOB = 37 * MiB;
constexpr size_t WS_WGU = 41 * MiB;
constexpr size_t WS_WD = 85 * MiB;
constexpr size_t WS_XS = 112 * MiB;
constexpr size_t WS_Q = 240 * MiB;
constexpr size_t WS_K = 368 * MiB;
constexpr size_t WS_VT = 496 * MiB;
constexpr size_t WS_HID = 240 * MiB;
constexpr size_t WS_END = 624 * MiB;
constexpr int LDS_BYTES = 139264;

struct Args {
    const float* x; const float* c; const int* pos; const float* ada_w; const float* ada_b; const float* n1g; const float* n2g;
    const float* wqkv_a; const float* qn_a; const float* kn_a; const float* sinks_a; const float* wo_a; const float* wqkv_b; const float* wo_b;
    const float* w_gate; const float* w_up; const float* w_down;
    float* out; unsigned char* ws; int ph_lo, ph_hi;
};

__constant__ float INVF[8] = {1.0f, 0.1939227432012558f, 0.03760603070259094f, 0.007292664609849453f, 0.0014142135623842478f, 0.00027424818836152554f, 5.318296098266728e-05f, 1.0313386155758053e-05f};

__device__ __forceinline__ float wave_sum(float v) {
#pragma unroll
    for (int o = 1; o < 64; o <<= 1) v += __shfl_xor(v, o);
    return v;
}
__device__ __forceinline__ float bf2f(unsigned short h) { return __uint_as_float((unsigned)h << 16); }
__device__ __forceinline__ float rstd_row(const float* ssq, int row) {
    const f32x4* p = (const f32x4*)(ssq + (size_t)row * 16);
    const f32x4 a = p[0], b = p[1], c = p[2], d = p[3];
    const float s = (((a.x + a.y) + (a.z + a.w)) + ((b.x + b.y) + (b.z + b.w))) + (((c.x + c.y) + (c.z + c.w)) + ((d.x + d.y) + (d.z + d.w)));
    return rsqrtf(s * (1.0f / DM) + EPS);
}
__device__ __forceinline__ u32x4 pack8(const f32x4& a, const f32x4& b) { u32x4 w; w.x = cvt_pk_bf16(a[0], a[1]); w.y = cvt_pk_bf16(a[2], a[3]); w.z = cvt_pk_bf16(b[0], b[1]); w.w = cvt_pk_bf16(b[2], b[3]); return w; }

struct EpiQKVA {
    static constexpr bool PERM = true, AFTER_DRAIN = false;
    bf16_t* Q; bf16_t* Kb; const float* ssq; const float* shw; const float* qg; const float* kg; const float* cs;
    __device__ __forceinline__ void operator()(const f32x4 (&acc)[2][2][4][2], const Unit& u, int wr, int wc, int fr, int fq) const {
        if (u.pn == 4 && wc >= 2) return;
        const int b = u.pm >> 4; const bool isk = (u.pn == 4);
        const float* gain = isk ? kg : qg; const float qs = isk ? 1.0f : 0.125f;
        f32x4 bv[2][2], gv[2][2];
#pragma unroll
        for (int bj = 0; bj < 2; ++bj)
#pragma unroll
            for (int n = 0; n < 2; ++n) { bv[bj][n] = *(const f32x4*)(shw + b * SHW1_LD + u.pn * 256 + bj * 128 + wc * 32 + 8 * fq + 4 * n); gv[bj][n] = *(const f32x4*)(gain + 16 * fq + 8 * bj + 4 * n); }
#pragma unroll
        for (int ai = 0; ai < 2; ++ai)
#pragma unroll
            for (int m = 0; m < 4; ++m) {
                const int row = u.pm * 256 + ai * 128 + wr * 64 + m * 16 + fr;
                const float rs = rstd_row(ssq, row);
                f32x4 v[2][2]; float ss = 0.f;
#pragma unroll
                for (int bj = 0; bj < 2; ++bj)
#pragma unroll
                    for (int n = 0; n < 2; ++n) { v[bj][n] = acc[ai][bj][m][n] * rs + bv[bj][n]; const f32x4 t = v[bj][n]; ss += (t[0] * t[0] + t[1] * t[1]) + (t[2] * t[2] + t[3] * t[3]); }
                ss += __shfl_xor(ss, 16); ss += __shfl_xor(ss, 32);
                const float hr = rsqrtf(ss * (1.0f / HD) + EPS);
#pragma unroll
                for (int bj = 0; bj < 2; ++bj)
#pragma unroll
                    for (int n = 0; n < 2; ++n) v[bj][n] = v[bj][n] * hr * gv[bj][n];
                if (fq == 0) {
                    const f32x4* cp = (const f32x4*)(cs + (size_t)row * 16);
#pragma unroll
                    for (int n = 0; n < 2; ++n) { const f32x4 cc = cp[n], sn = cp[2 + n]; const f32x4 x1 = v[0][n], x2 = v[1][n]; v[0][n] = x1 * cc - x2 * sn; v[1][n] = x2 * cc + x1 * sn; }
                }
                bf16_t* dst = isk ? (Kb + (size_t)row * 128 + wc * 64) : (Q + (size_t)row * DM + (4 * u.pn + wc) * 64);
#pragma unroll
                for (int bj = 0; bj < 2; ++bj) *(u32x4*)(dst + 16 * fq + 8 * bj) = pack8(v[bj][0] * qs, v[bj][1] * qs);
            }
    }
};
struct EpiQKB {
    static constexpr bool PERM = true, AFTER_DRAIN = false;
    bf16_t* Q; bf16_t* Kb; const float* ssq; const float* shw;
    __device__ __forceinline__ void operator()(const f32x4 (&acc)[2][2][4][2], const Unit& u, int wr, int wc, int fr, int fq) const {
        const int b = u.pm >> 4; const bool isk = (u.pn >= 4); const float qs = isk ? 1.0f : 0.125f;
        bf16_t* base = (isk ? Kb : Q) + (u.pn & 3) * 256 + wc * 32 + 8 * fq;
        f32x4 bv[2][2];
#pragma unroll
        for (int bj = 0; bj < 2; ++bj)
#pragma unroll
            for (int n = 0; n < 2; ++n) bv[bj][n] = *(const f32x4*)(shw + b * SHW1_LD + u.pn * 256 + bj * 128 + wc * 32 + 8 * fq + 4 * n);
#pragma unroll
        for (int ai = 0; ai < 2; ++ai)
#pragma unroll
            for (int m = 0; m < 4; ++m) {
                const int row = u.pm * 256 + ai * 128 + wr * 64 + m * 16 + fr;
                const float rs = rstd_row(ssq, row) * qs;
#pragma unroll
                for (int bj = 0; bj < 2; ++bj) *(u32x4*)(base + (size_t)row * DM + bj * 128) = pack8(acc[ai][bj][m][0] * rs + bv[bj][0] * qs, acc[ai][bj][m][1] * rs + bv[bj][1] * qs);
            }
    }
};
template <bool MODE_A> struct EpiVT {
    static constexpr bool PERM = true, AFTER_DRAIN = false;
    bf16_t* VT; const float* ssq; const float* shw;
    __device__ __forceinline__ void operator()(const f32x4 (&acc)[2][2][4][2], const Unit& u, int wr, int wc, int fr, int fq) const {
        if (MODE_A && wr == 0) return;
        const int lane = fr + 16 * fq; const int b = u.pn >> 4;
        const float myrs = rstd_row(ssq, u.pn * 256 + (lane >> 5) * 128 + wc * 32 + (lane & 31));
        constexpr int NH = MODE_A ? 2 : 16;
#pragma unroll
        for (int bj = 0; bj < 2; ++bj) {
            float rs[8];
#pragma unroll
            for (int e = 0; e < 8; ++e) rs[e] = __shfl(myrs, bj * 32 + 8 * fq + e);
            const int t = (u.pn & 15) * 256 + bj * 128 + wc * 32 + 8 * fq;
#pragma unroll
            for (int ai = 0; ai < 2; ++ai)
#pragma unroll
                for (int m = 0; m < 4; ++m) {
                    int head, dim, bidx;
                    if (MODE_A) { const int rho = ai * 128 + wr * 64 + m * 16 + fr; head = ((rho >> 5) & 3) - 2; dim = 16 * ((rho & 31) >> 3) + 8 * ai + (rho & 7); bidx = 1024 + rho; }
                    else { const int vrow = u.pm * 256 + ai * 128 + wr * 64 + m * 16 + fr; head = vrow >> 6; dim = vrow & 63; bidx = 2048 + vrow; }
                    const float bias = shw[b * SHW1_LD + bidx];
                    const f32x4 a0 = acc[ai][bj][m][0], a1 = acc[ai][bj][m][1];
                    const f32x4 v0 = {a0[0] * rs[0] + bias, a0[1] * rs[1] + bias, a0[2] * rs[2] + bias, a0[3] * rs[3] + bias};
                    const f32x4 v1 = {a1[0] * rs[4] + bias, a1[1] * rs[5] + bias, a1[2] * rs[6] + bias, a1[3] * rs[7] + bias};
                    *(u32x4*)(VT + ((((size_t)(b * NH + head) * 64 + (t >> 6)) * 64 + dim) * 64 + (t & 63))) = pack8(v0, v1);
                }
        }
    }
};
struct EpiRes {
    static constexpr bool PERM = false, AFTER_DRAIN = false;
    const float* base; float* out; const float* gate; const float* gsn; bf16_t* xs; float* ssq; int has_next;
    __device__ __forceinline__ void operator()(const f32x4 (&acc)[2][2][4][2], const Unit& u, int wr, int wc, int fr, int fq) const {
        const int b = u.pm >> 4; const int col0 = u.pn * 256 + wc * 32 + 4 * fq;
        f32x4 gv[2][2], sv[2][2];
#pragma unroll
        for (int bj = 0; bj < 2; ++bj)
#pragma unroll
            for (int n = 0; n < 2; ++n) { gv[bj][n] = *(const f32x4*)(gate + b * NMOD + col0 + bj * 128 + n * 16); sv[bj][n] = has_next ? *(const f32x4*)(gsn + b * DM + col0 + bj * 128 + n * 16) : (f32x4){0.f, 0.f, 0.f, 0.f}; }
#pragma unroll
        for (int ai = 0; ai < 2; ++ai)
#pragma unroll
            for (int m = 0; m < 4; ++m) {
                const int row = u.pm * 256 + ai * 128 + wr * 64 + m * 16 + fr; const size_t off = (size_t)row * DM + col0; float ss = 0.f;
#pragma unroll
                for (int bj = 0; bj < 2; ++bj)
#pragma unroll
                    for (int n = 0; n < 2; ++n) {
                        const f32x4 xo = *(const f32x4*)(base + off + bj * 128 + n * 16);
                        const f32x4 xn = xo + gv[bj][n] * acc[ai][bj][m][n];
                        *(f32x4*)(out + off + bj * 128 + n * 16) = xn;
                        ss += (xn[0] * xn[0] + xn[1] * xn[1]) + (xn[2] * xn[2] + xn[3] * xn[3]);
                        if (has_next) { const f32x4 y = xn * sv[bj][n]; u32x2 w; w.x = cvt_pk_bf16(y[0], y[1]); w.y = cvt_pk_bf16(y[2], y[3]); *(u32x2*)(xs + off + bj * 128 + n * 16) = w; }
                    }
                ss += __shfl_xor(ss, 16); ss += __shfl_xor(ss, 32);
                if (has_next && fq == 0) ssq[(size_t)row * 16 + u.pn * 4 + wc] = ss;
                asm volatile("" ::: "memory");
            }
    }
};
struct EpiSwiGLU {
    static constexpr bool PERM = true, AFTER_DRAIN = false;
    bf16_t* hid; const float* ssq; const float* shw;
    __device__ __forceinline__ void operator()(const f32x4 (&acc)[2][2][4][2], const Unit& u, int wr, int wc, int fr, int fq) const {
        const int b = u.pm >> 4;
        f32x4 bg[2], bu[2];
#pragma unroll
        for (int n = 0; n < 2; ++n) { bg[n] = *(const f32x4*)(shw + b * NGU + u.pn * 256 + wc * 32 + 8 * fq + 4 * n); bu[n] = *(const f32x4*)(shw + b * NGU + u.pn * 256 + 128 + wc * 32 + 8 * fq + 4 * n); }
#pragma unroll
        for (int ai = 0; ai < 2; ++ai)
#pragma unroll
            for (int m = 0; m < 4; ++m) {
                const int row = u.pm * 256 + ai * 128 + wr * 64 + m * 16 + fr;
                const float rs = rstd_row(ssq, row);
                f32x4 h[2];
#pragma unroll
                for (int n = 0; n < 2; ++n) {
                    const f32x4 g = acc[ai][0][m][n] * rs + bg[n], up = acc[ai][1][m][n] * rs + bu[n];
#pragma unroll
                    for (int j = 0; j < 4; ++j) h[n][j] = g[j] * __builtin_amdgcn_rcpf(1.0f + __expf(-g[j])) * up[j];
                }
                *(u32x4*)(hid + (size_t)row * DFF + u.pn * 128 + wc * 32 + 8 * fq) = pack8(h[0], h[1]);
            }
    }
};

__device__ __forceinline__ int dest_row(int kind, int n) {
    if (kind == 1) { const int hh = n >> 6, dim = n & 63; return 256 * (hh >> 2) + 128 * ((dim >> 3) & 1) + 32 * (hh & 3) + 8 * (dim >> 4) + (dim & 7); }
    if (kind == 3) return 256 * (n >> 7) + (n & 127);
    if (kind == 4) return 256 * (n >> 7) + 128 + (n & 127);
    return n;
}
__device__ __forceinline__ void transpose_item(const float* W, int K, int N, bf16_t* WT, int kind, int rowoff, LAS float* scr, int item, int lane) {
    const int nblk = N / 32, kb = item / nblk, nb = item % nblk, k0 = 64 * kb, n0 = 32 * nb;
#pragma unroll 8
    for (int i = 0; i < 32; ++i) { const int kk = 2 * i + (lane >> 5); scr[kk * 33 + (lane & 31)] = W[(size_t)(k0 + kk) * N + n0 + (lane & 31)]; }
    asm volatile("s_waitcnt lgkmcnt(0)" ::: "memory");
    const int c = lane & 7;
#pragma unroll
    for (int j = 0; j < 4; ++j) { const int n = (lane >> 3) + 8 * j; const LAS float* s = scr + (8 * c) * 33 + n;
        u32x4 o; o.x = cvt_pk_bf16(s[0 * 33], s[1 * 33]); o.y = cvt_pk_bf16(s[2 * 33], s[3 * 33]); o.z = cvt_pk_bf16(s[4 * 33], s[5 * 33]); o.w = cvt_pk_bf16(s[6 * 33], s[7 * 33]);
        *(u32x4*)(WT + (size_t)(dest_row(kind, n0 + n) + rowoff) * K + k0 + 8 * c) = o; }
    asm volatile("s_waitcnt lgkmcnt(0)" ::: "memory");
}

__device__ __forceinline__ void phase_p0(const Args& a, LAS unsigned char* lds, int tid, int lane, int wave) {
    unsigned char* ws = a.ws;
    { float* cs = (float*)(ws + WS_CS);
      for (int i = blockIdx.x * 512 + tid; i < NTOK * 8; i += gridDim.x * 512) {
          const int t = i >> 3, e = i & 7; const float ang = (float)a.pos[t] * INVF[e];
          const float n = rintf(ang * 0.15915494309189535f); float r = fmaf(-n, 6.2831854820251465f, ang); r = fmaf(-n, -1.7484556000744487e-07f, r);
          cs[(size_t)t * 16 + e] = __cosf(r); cs[(size_t)t * 16 + 8 + e] = __sinf(r); } }
    { LAS float* sc = (LAS float*)lds;
      LAS float* red = (LAS float*)(lds + 65536);
      for (int i = tid; i < NB * DM; i += 512) { const int b = i >> 10, k = i & 1023; const float v = a.c[i]; sc[k * 16 + b] = v / (1.0f + __expf(-v)); }
      __syncthreads();
      float* mod = (float*)(ws + WS_MOD);
      for (int item = blockIdx.x; item < DEPTH * (NMOD / 64); item += gridDim.x) {
          const int l = item / (NMOD / 64), n = (item % (NMOD / 64)) * 64 + lane;
          float acc[16];
#pragma unroll
          for (int b = 0; b < 16; ++b) acc[b] = 0.f;
          const float* wp = a.ada_w + ((size_t)l * DM + wave * 128) * NMOD + n;
#pragma unroll 8
          for (int k = 0; k < 128; ++k) { const float w = wp[(size_t)k * NMOD]; const LAS f32x4* s = (const LAS f32x4*)(sc + (wave * 128 + k) * 16);
#pragma unroll
              for (int q = 0; q < 4; ++q) { const f32x4 sv = s[q]; acc[4 * q + 0] += sv[0] * w; acc[4 * q + 1] += sv[1] * w; acc[4 * q + 2] += sv[2] * w; acc[4 * q + 3] += sv[3] * w; } }
#pragma unroll
          for (int b = 0; b < 16; ++b) red[(wave * 16 + b) * 64 + lane] = acc[b];
          __syncthreads();
          for (int o = tid; o < 16 * 64; o += 512) { const int b = o >> 6, nn = o & 63; float s = 0.f;
#pragma unroll
              for (int w = 0; w < 8; ++w) s += red[(w * 16 + b) * 64 + nn];
              const int col = (item % (NMOD / 64)) * 64 + nn; mod[((size_t)l * NB + b) * NMOD + col] = s + a.ada_b[l * NMOD + col]; }
          __syncthreads();
      } }
    __syncthreads();
    { LAS float* scr = (LAS float*)(lds + wave * 16384);
      const int gw = blockIdx.x * 8 + wave, NGW = gridDim.x * 8;
      constexpr int I_QA = 16 * 40, I_O = 16 * 32, I_QB = 16 * 96, I_G = 16 * 88, I_D = 44 * 32;
      constexpr int NIT = 2 * I_QA + 2 * I_O + 2 * I_QB + 2 * I_O + 4 * I_G + 4 * I_G + 4 * I_D;
      for (int it = gw; it < NIT; it += NGW) {
          int r = it;
          if (r < 2 * I_QA) { const int j = r / I_QA; transpose_item(a.wqkv_a + (size_t)j * DM * NQKVA, DM, NQKVA, (bf16_t*)(ws + WS_WQKVA) + (size_t)j * NQKVA * DM, 1, 0, scr, r % I_QA, lane); continue; } r -= 2 * I_QA;
          if (r < 2 * I_O) { const int j = r / I_O; transpose_item(a.wo_a + (size_t)j * DM * DM, DM, DM, (bf16_t*)(ws + WS_WOA) + (size_t)j * DM * DM, 0, 0, scr, r % I_O, lane); continue; } r -= 2 * I_O;
          if (r < 2 * I_QB) { const int j = r / I_QB, ii = r % I_QB; const bool isv = (ii % 96) >= 64;
              transpose_item(a.wqkv_b + (size_t)j * DM * NQKVB, DM, NQKVB, isv ? (bf16_t*)(ws + WS_WVB) + (size_t)j * DM * DM : (bf16_t*)(ws + WS_WQKB) + (size_t)j * 2048 * DM, 0, isv ? -2048 : 0, scr, ii, lane); continue; } r -= 2 * I_QB;
          if (r < 2 * I_O) { const int j = r / I_O; transpose_item(a.wo_b + (size_t)j * DM * DM, DM, DM, (bf16_t*)(ws + WS_WOB) + (size_t)j * DM * DM, 0, 0, scr, r % I_O, lane); continue; } r -= 2 * I_O;
          if (r < 4 * I_G) { const int l = r / I_G; transpose_item(a.w_gate + (size_t)l * DM * DFF, DM, DFF, (bf16_t*)(ws + WS_WGU) + (size_t)l * NGU * DM, 3, 0, scr, r % I_G, lane); continue; } r -= 4 * I_G;
          if (r < 4 * I_G) { const int l = r / I_G; transpose_item(a.w_up + (size_t)l * DM * DFF, DM, DFF, (bf16_t*)(ws + WS_WGU) + (size_t)l * NGU * DM, 4, 0, scr, r % I_G, lane); continue; } r -= 4 * I_G;
          { const int l = r / I_D; transpose_item(a.w_down + (size_t)l * DFF * DM, DFF, DM, (bf16_t*)(ws + WS_WD) + (size_t)l * DM * DFF, 0, 0, scr, r % I_D, lane); }
      } }
}

__device__ __forceinline__ void phase_p1(const Args& a, int tid, int lane, int wave) {
    unsigned char* ws = a.ws; const float* mod = (const float*)(ws + WS_MOD);
    { float* gs = (float*)(ws + WS_GS);
      for (int i = blockIdx.x * 512 + tid; i < DEPTH * 2 * NB * DM; i += gridDim.x * 512) {
          const int k = i & 1023, b = (i >> 10) & 15, s = (i >> 14) & 1, l = i >> 15;
          gs[i] = (s ? a.n2g : a.n1g)[l * DM + k] * (1.0f + mod[((size_t)l * NB + b) * NMOD + (s ? 4096 : 1024) + k]); } }
    const int gw = blockIdx.x * 8 + wave, NGW = gridDim.x * 8;
    { constexpr int RA = NQKVA + NGU, RB = NQKVB + NGU, RP = RA + RB;
      for (int r = gw; r < 2 * RP; r += NGW) {
          const int p = r / RP; int rr = r % RP; int l, n, shoff, ld; const bf16_t* wrow; float* outp;
          if (rr < RA) { l = 2 * p;
              if (rr < NQKVA) { n = rr; wrow = (const bf16_t*)(ws + WS_WQKVA) + ((size_t)p * NQKVA + n) * DM; shoff = 0; ld = SHW1_LD; outp = (float*)(ws + WS_SHW1) + (size_t)l * NB * SHW1_LD; }
              else { n = rr - NQKVA; wrow = (const bf16_t*)(ws + WS_WGU) + ((size_t)l * NGU + n) * DM; shoff = 3072; ld = NGU; outp = (float*)(ws + WS_SHW3) + (size_t)l * NB * NGU; } }
          else { rr -= RA; l = 2 * p + 1;
              if (rr < NQKVB) { n = rr; wrow = (n < 2048) ? (const bf16_t*)(ws + WS_WQKB) + ((size_t)p * 2048 + n) * DM : (const bf16_t*)(ws + WS_WVB) + ((size_t)p * DM + (n - 2048)) * DM; shoff = 0; ld = SHW1_LD; outp = (float*)(ws + WS_SHW1) + (size_t)l * NB * SHW1_LD; }
              else { n = rr - NQKVB; wrow = (const bf16_t*)(ws + WS_WGU) + ((size_t)l * NGU + n) * DM; shoff = 3072; ld = NGU; outp = (float*)(ws + WS_SHW3) + (size_t)l * NB * NGU; } }
          const u32x4 w0 = *(const u32x4*)(wrow + 16 * lane), w1 = *(const u32x4*)(wrow + 16 * lane + 8);
          float wf[16];
#pragma unroll
          for (int q = 0; q < 4; ++q) { wf[2 * q] = __uint_as_float(w0[q] << 16); wf[2 * q + 1] = __uint_as_float(w0[q] & 0xffff0000u); wf[8 + 2 * q] = __uint_as_float(w1[q] << 16); wf[8 + 2 * q + 1] = __uint_as_float(w1[q] & 0xffff0000u); }
          float res = 0.f;
          for (int b = 0; b < NB; ++b) {
              const f32x4* sp = (const f32x4*)(mod + ((size_t)l * NB + b) * NMOD + shoff + 16 * lane); float d = 0.f;
#pragma unroll
              for (int q = 0; q < 4; ++q) { const f32x4 sv = sp[q]; d += sv[0] * wf[4 * q] + sv[1] * wf[4 * q + 1] + sv[2] * wf[4 * q + 2] + sv[3] * wf[4 * q + 3]; }
              d = wave_sum(d); if (lane == b) res = d; }
          if (lane < NB) outp[(size_t)lane * ld + n] = res;
      } }
    { bf16_t* xs = (bf16_t*)(ws + WS_XS); float* ssq = (float*)(ws + WS_SSQ);
      for (int m = gw; m < NTOK; m += NGW) {
          const int b = m >> 12; const f32x4* xr = (const f32x4*)(a.x + (size_t)m * DM) + lane; float s = 0.f;
#pragma unroll
          for (int j = 0; j < 4; ++j) { const f32x4 v = xr[64 * j]; s += (v[0] * v[0] + v[1] * v[1]) + (v[2] * v[2] + v[3] * v[3]);
              const int col = 4 * lane + 256 * j; const f32x4 g = *(const f32x4*)(a.n1g + col), scv = *(const f32x4*)(mod + (size_t)b * NMOD + 1024 + col);
              const f32x4 y = v * (g * (1.0f + scv)); u32x2 w; w.x = cvt_pk_bf16(y[0], y[1]); w.y = cvt_pk_bf16(y[2], y[3]); *(u32x2*)(xs + (size_t)m * DM + col) = w; }
          s = wave_sum(s); if (lane < 16) ssq[(size_t)m * 16 + lane] = (lane == 0) ? s : 0.f; } }
}

__device__ __forceinline__ int pi32(int i) { return ((i >> 2) & 1) * 16 + (i >> 3) * 4 + (i & 3); }
#define MFMA32(a_, b_, c_) __builtin_amdgcn_mfma_f32_32x32x16_bf16((a_), (b_), (c_), 0, 0, 0)
__device__ __forceinline__ bf16x8 pack_p(const f32x16& p, int s2) {
    u32x4 w;
    if (s2 == 0) { w.x = cvt_pk_bf16(p[0], p[1]); w.y = cvt_pk_bf16(p[2], p[3]); w.z = cvt_pk_bf16(p[4], p[5]); w.w = cvt_pk_bf16(p[6], p[7]); }
    else { w.x = cvt_pk_bf16(p[8], p[9]); w.y = cvt_pk_bf16(p[10], p[11]); w.z = cvt_pk_bf16(p[12], p[13]); w.w = cvt_pk_bf16(p[14], p[15]); }
    return __builtin_bit_cast(bf16x8, w);
}
__device__ __forceinline__ void store_o(bf16_t* op, const f32x16& o0, const f32x16& o1, float sc) {
    u32x4 w;
    w.x = cvt_pk_bf16(o0[0] * sc, o0[1] * sc); w.y = cvt_pk_bf16(o0[2] * sc, o0[3] * sc); w.z = cvt_pk_bf16(o0[4] * sc, o0[5] * sc); w.w = cvt_pk_bf16(o0[6] * sc, o0[7] * sc); *(u32x4*)(op) = w;
    w.x = cvt_pk_bf16(o0[8] * sc, o0[9] * sc); w.y = cvt_pk_bf16(o0[10] * sc, o0[11] * sc); w.z = cvt_pk_bf16(o0[12] * sc, o0[13] * sc); w.w = cvt_pk_bf16(o0[14] * sc, o0[15] * sc); *(u32x4*)(op + 8) = w;
    w.x = cvt_pk_bf16(o1[0] * sc, o1[1] * sc); w.y = cvt_pk_bf16(o1[2] * sc, o1[3] * sc); w.z = cvt_pk_bf16(o1[4] * sc, o1[5] * sc); w.w = cvt_pk_bf16(o1[6] * sc, o1[7] * sc); *(u32x4*)(op + 32) = w;
    w.x = cvt_pk_bf16(o1[8] * sc, o1[9] * sc); w.y = cvt_pk_bf16(o1[10] * sc, o1[11] * sc); w.z = cvt_pk_bf16(o1[12] * sc, o1[13] * sc); w.w = cvt_pk_bf16(o1[14] * sc, o1[15] * sc); *(u32x4*)(op + 40) = w;
}
__device__ __forceinline__ void attn_a_phase(const bf16_t* Q, const bf16_t* Kb, const bf16_t* VT, bf16_t* O, const float* sinks, int wave, int lane) {
    const int gw = blockIdx.x * 8 + wave, NGW = gridDim.x * 8;
    const int ql = lane & 31, hi = lane >> 5, pk = pi32(ql);
    const float NEG = -__builtin_inff();
    for (int task = gw; task < NB * 2 * 128; task += NGW) {
        const int blk = task & 127, kvh = (task >> 7) & 1, b = task >> 8;
        const size_t row0 = (size_t)b * SEQ + blk * 32;
        for (int g = 0; g < 8; ++g) {
            const int head = kvh * 8 + g;
            const bf16_t* qp = Q + (row0 + ql) * DM + head * 64 + hi * 8;
            bf16x8 qf[4];
#pragma unroll
            for (int kk = 0; kk < 4; ++kk) qf[kk] = *(const bf16x8*)(qp + kk * 16);
            f32x16 s[5];
#pragma unroll
            for (int i = 0; i < 5; ++i) {
                const int kt = blk - 4 + i;
                if (kt >= 0) {
                    const bf16_t* kp = Kb + ((size_t)b * SEQ + kt * 32 + pk) * 128 + kvh * 64 + hi * 8;
                    f32x16 z;
#pragma unroll
                    for (int r = 0; r < 16; ++r) z[r] = 0.f;
#pragma unroll
                    for (int kk = 0; kk < 4; ++kk) z = MFMA32(*(const bf16x8*)(kp + kk * 16), qf[kk], z);
                    s[i] = z;
                } else {
#pragma unroll
                    for (int r = 0; r < 16; ++r) s[i][r] = NEG;
                }
            }
#pragma unroll
            for (int r = 0; r < 16; ++r) { const int kl = 16 * hi + r; if (!(kl > ql)) s[0][r] = NEG; if (!(kl <= ql)) s[4][r] = NEG; }
            const float sink = sinks[head];
            float mx = sink;
#pragma unroll
            for (int i = 0; i < 5; ++i)
#pragma unroll
                for (int r = 0; r < 16; ++r) mx = fmaxf(mx, s[i][r]);
            mx = fmaxf(mx, __shfl_xor(mx, 32));
            float den = 0.f;
#pragma unroll
            for (int i = 0; i < 5; ++i)
#pragma unroll
                for (int r = 0; r < 16; ++r) { const float p = __expf(s[i][r] - mx); s[i][r] = p; den += p; }
            den += __shfl_xor(den, 32); den += __expf(sink - mx);
            f32x16 o0, o1;
#pragma unroll
            for (int r = 0; r < 16; ++r) { o0[r] = 0.f; o1[r] = 0.f; }
#pragma unroll
            for (int i = 0; i < 5; ++i) {
                const int kt = blk - 4 + i;
                if (kt >= 0) {
                    const int key0 = kt * 32;
                    const bf16_t* vb = VT + (((size_t)(b * 2 + kvh) * 64 + (key0 >> 6)) * 64) * 64 + (key0 & 63) + 16 * hi;
#pragma unroll
                    for (int s2 = 0; s2 < 2; ++s2) { const bf16x8 pb = pack_p(s[i], s2);
                        o0 = MFMA32(*(const bf16x8*)(vb + pk * 64 + 8 * s2), pb, o0); o1 = MFMA32(*(const bf16x8*)(vb + (32 + pk) * 64 + 8 * s2), pb, o1); }
                }
            }
            store_o(O + (row0 + ql) * DM + head * 64 + 16 * hi, o0, o1, 1.0f / den);
        }
    }
}
__device__ __forceinline__ void attn_b_phase(const bf16_t* Q, const bf16_t* Kb, const bf16_t* VT, bf16_t* O, int wave, int lane) {
    const int gw = blockIdx.x * 8 + wave, NGW = gridDim.x * 8;
    const int ql = lane & 31, hi = lane >> 5, pk = pi32(ql);
    int it = 0;
    for (int task = gw; task < NB * 16 * 128; task += NGW, ++it) {
        const int bh = task >> 7; int blk = task & 127; if (it & 1) blk = 127 - blk;
        const int b = bh >> 4, h = bh & 15;
        const size_t row0 = (size_t)b * SEQ + blk * 32;
        const bf16_t* qp = Q + (row0 + ql) * DM + h * 64 + hi * 8;
        bf16x8 qf[4];
#pragma unroll
        for (int kk = 0; kk < 4; ++kk) qf[kk] = *(const bf16x8*)(qp + kk * 16);
        const bf16_t* kbase = Kb + ((size_t)b * SEQ + pk) * DM + h * 64 + hi * 8;
        const bf16_t* vbase = VT + ((size_t)(b * 16 + h) * 64) * 4096 + 16 * hi;
        f32x16 o0, o1;
#pragma unroll
        for (int r = 0; r < 16; ++r) { o0[r] = 0.f; o1[r] = 0.f; }
        float carry = 0.f;
        bf16x8 kn[4];
#pragma unroll
        for (int kk = 0; kk < 4; ++kk) kn[kk] = *(const bf16x8*)(kbase + (size_t)blk * 32 * DM + kk * 16);
        for (int kt = blk; kt >= 0; --kt) {
            bf16x8 kf[4];
#pragma unroll
            for (int kk = 0; kk < 4; ++kk) kf[kk] = kn[kk];
            if (kt > 0) {
#pragma unroll
                for (int kk = 0; kk < 4; ++kk) kn[kk] = *(const bf16x8*)(kbase + (size_t)(kt - 1) * 32 * DM + kk * 16);
            }
            const int key0 = kt * 32;
            const bf16_t* vb = vbase + (size_t)(key0 >> 6) * 4096 + (key0 & 63);
            const bf16x8 v00 = *(const bf16x8*)(vb + pk * 64), v01 = *(const bf16x8*)(vb + pk * 64 + 8), v10 = *(const bf16x8*)(vb + (32 + pk) * 64), v11 = *(const bf16x8*)(vb + (32 + pk) * 64 + 8);
            f32x16 z;
#pragma unroll
            for (int r = 0; r < 16; ++r) z[r] = 0.f;
#pragma unroll
            for (int kk = 0; kk < 4; ++kk) z = MFMA32(kf[kk], qf[kk], z);
            const bool diag = (kt == blk);
            f32x16 af;
            float run = 0.f;
#pragma unroll
            for (int r = 15; r >= 0; --r) {
                const float zz = z[r]; const float e = __expf(-fabsf(zz)); const float sp = fmaxf(zz, 0.f) + __logf(1.0f + e);
                const bool valid = !diag || (16 * hi + r < ql);
                z[r] = zz - sp;
                af[r] = run; run += valid ? -sp : 0.f;
            }
            const float other = __shfl_xor(run, 32);
            const float base = carry + (hi == 0 ? other : 0.f);
            f32x16 p;
#pragma unroll
            for (int r = 0; r < 16; ++r) { const bool valid = !diag || (16 * hi + r < ql); p[r] = valid ? __expf(z[r] + af[r] + base) : 0.f; }
            carry += run + other;
            const bf16x8 pb0 = pack_p(p, 0), pb1 = pack_p(p, 1);
            o0 = MFMA32(v00, pb0, o0); o0 = MFMA32(v01, pb1, o0); o1 = MFMA32(v10, pb0, o1); o1 = MFMA32(v11, pb1, o1);
            if (__all(carry < -110.0f)) break;
        }
        store_o(O + (row0 + ql) * DM + h * 64 + 16 * hi, o0, o1, 1.0f);
    }
}

__device__ __forceinline__ Args load_args() {
#if defined(__HIP_DEVICE_COMPILE__)
    const __attribute__((address_space(4))) Args* ap = (const __attribute__((address_space(4))) Args*)__builtin_amdgcn_kernarg_segment_ptr();
    asm volatile("" : "+s"(ap));
    return *ap;
#else
    return Args{};
#endif
}
__global__ void __launch_bounds__(512, 2) mk_fwd(Args a0) {
    extern __shared__ __attribute__((aligned(16))) unsigned char lds_raw[];
    LAS unsigned char* lds = (LAS unsigned char*)lds_raw;
    cg::grid_group grid = cg::this_grid();
    const int wave0 = __builtin_amdgcn_readfirstlane(threadIdx.x >> 6);
    const int ph_lo = a0.ph_lo, ph_hi = a0.ph_hi;
    for (int ph = ph_lo; ph < ph_hi; ++ph) {
        if (ph > ph_lo) grid.sync();
        int tid; asm volatile("v_mbcnt_lo_u32_b32 %0, -1, 0\n\tv_mbcnt_hi_u32_b32 %0, -1, %0" : "=v"(tid)); tid += wave0 * 64;
        const int lane = tid & 63, wave = __builtin_amdgcn_readfirstlane(tid >> 6);
        const Args a = load_args();
        unsigned char* ws = a.ws;
        bf16_t* XS = (bf16_t*)(ws + WS_XS); bf16_t* QB = (bf16_t*)(ws + WS_Q); bf16_t* KB = (bf16_t*)(ws + WS_K); bf16_t* VT = (bf16_t*)(ws + WS_VT); bf16_t* HID = (bf16_t*)(ws + WS_HID);
        float* SSQ = (float*)(ws + WS_SSQ); const float* MOD = (const float*)(ws + WS_MOD); const float* GS = (const float*)(ws + WS_GS);
        if (ph == 0) {
#ifndef SKIP_P0
 phase_p0(a, lds, tid, lane, wave);
#endif
 continue; }
        if (ph == 1) {
#ifndef SKIP_P1
 phase_p1(a, tid, lane, wave);
#endif
 continue; }
        const int l = (ph - 2) / 5, sub = (ph - 2) % 5, p = l >> 1; const bool isA = (l & 1) == 0;
        const float* shw1 = (const float*)(ws + WS_SHW1) + (size_t)l * NB * SHW1_LD;
        if (sub == 0) {
            if (isA) {
                const bf16_t* W = (const bf16_t*)(ws + WS_WQKVA) + (size_t)p * NQKVA * DM;
                { pg8::Gemm g{XS, W, NTOK, NQKVA, DM}; pg8::StaticOrder S; S.init(NTOK, NQKVA, gridDim.x, blockIdx.x);
                  EpiQKVA E{QB, KB, SSQ, shw1, a.qn_a + p * HD, a.kn_a + p * HD, (const float*)(ws + WS_CS)};

#ifndef SKIP_G1A
pg8::gemm_phase<EpiQKVA, pg8::StaticOrder, true, true>(lds, g, S, E, tid);
#endif
 }
                { pg8::Gemm g{W + (size_t)1024 * DM, XS, 256, NTOK, DM}; pg8::StaticOrder S; S.init(256, NTOK, gridDim.x, blockIdx.x);
                  EpiVT<true> E{VT, SSQ, shw1};

#ifndef SKIP_G1AV
pg8::gemm_phase<EpiVT<true>, pg8::StaticOrder, true, true>(lds, g, S, E, tid);
#endif
 }
            } else {
                { pg8::Gemm g{XS, (const bf16_t*)(ws + WS_WQKB) + (size_t)p * 2048 * DM, NTOK, 2048, DM}; pg8::StaticOrder S; S.init(NTOK, 2048, gridDim.x, blockIdx.x);
                  EpiQKB E{QB, KB, SSQ, shw1};

#ifndef SKIP_G1B
pg8::gemm_phase<EpiQKB, pg8::StaticOrder, true, true>(lds, g, S, E, tid);
#endif
 }
                { pg8::Gemm g{(const bf16_t*)(ws + WS_WVB) + (size_t)p * DM * DM, XS, DM, NTOK, DM}; pg8::StaticOrder S; S.init(DM, NTOK, gridDim.x, blockIdx.x);
                  EpiVT<false> E{VT, SSQ, shw1};

#ifndef SKIP_G1BV
pg8::gemm_phase<EpiVT<false>, pg8::StaticOrder, true, true>(lds, g, S, E, tid);
#endif
 }
            }
        } else if (sub == 1) {
#ifndef SKIP_ATTA
            if (isA) attn_a_phase(QB, KB, VT, QB, a.sinks_a + p * 16, wave, lane);
#endif
#ifndef SKIP_ATTB
            if (!isA) attn_b_phase(QB, KB, VT, QB, wave, lane);
#endif
        } else if (sub == 2) {
            const bf16_t* W = isA ? (const bf16_t*)(ws + WS_WOA) + (size_t)p * DM * DM : (const bf16_t*)(ws + WS_WOB) + (size_t)p * DM * DM;
            pg8::Gemm g{QB, W, NTOK, DM, DM}; pg8::StaticOrder S; S.init(NTOK, DM, gridDim.x, blockIdx.x);
            EpiRes E{l == 0 ? a.x : a.out, a.out, MOD + (size_t)l * NB * NMOD + 2048, GS + ((size_t)l * 2 + 1) * NB * DM, XS, SSQ, 1};
#ifndef SKIP_G2
            pg8::gemm_phase<EpiRes, pg8::StaticOrder, true, true>(lds, g, S, E, tid);
#endif

        } else if (sub == 3) {
            pg8::Gemm g{XS, (const bf16_t*)(ws + WS_WGU) + (size_t)l * NGU * DM, NTOK, NGU, DM}; pg8::StaticOrder S; S.init(NTOK, NGU, gridDim.x, blockIdx.x);
            EpiSwiGLU E{HID, SSQ, (const float*)(ws + WS_SHW3) + (size_t)l * NB * NGU};

#ifndef SKIP_G3
pg8::gemm_phase<EpiSwiGLU, pg8::StaticOrder, true, true>(lds, g, S, E, tid);
#endif

        } else {
            pg8::Gemm g{HID, (const bf16_t*)(ws + WS_WD) + (size_t)l * DM * DFF, NTOK, DM, DFF}; pg8::StaticOrder S; S.init(NTOK, DM, gridDim.x, blockIdx.x);
            EpiRes E{a.out, a.out, MOD + (size_t)l * NB * NMOD + 5120, GS + ((size_t)(l + 1) * 2) * NB * DM, XS, SSQ, l < DEPTH - 1 ? 1 : 0};
#ifndef SKIP_G4
            pg8::gemm_phase<EpiRes, pg8::StaticOrder, true, true>(lds, g, S, E, tid);
#endif

        }
    }
}

#ifndef MK_SPLIT
#define MK_SPLIT 0
#endif
extern "C" void kernel_launch(void* const* d_in, const int* in_sizes, int n_in, void* d_out, int out_size, void* d_ws, size_t ws_size, hipStream_t stream) {
    static int grid = 0;
    if (grid == 0) {
        if (n_in != 17 || in_sizes[0] != NTOK * DM || out_size != NTOK * DM || ws_size < WS_END) { fprintf(stderr, "kernel_launch: unexpected shapes / workspace (n_in %d, ws %zu)\n", n_in, ws_size); grid = -1; return; }
        int dev = 0, cus = 0, per_cu = 0;
        hipGetDevice(&dev); hipDeviceGetAttribute(&cus, hipDeviceAttributeMultiprocessorCount, dev);
        if (hipFuncSetAttribute((const void*)mk_fwd, hipFuncAttributeMaxDynamicSharedMemorySize, LDS_BYTES) != hipSuccess) { fprintf(stderr, "kernel_launch: hipFuncSetAttribute failed\n"); grid = -1; return; }
        if (hipOccupancyMaxActiveBlocksPerMultiprocessor(&per_cu, (const void*)mk_fwd, 512, LDS_BYTES) != hipSuccess || per_cu < 1) { fprintf(stderr, "kernel_launch: occupancy query says %d\n", per_cu); per_cu = 1; }
        (void)hipGetLastError();
        grid = cus * 1;
    }
    if (grid < 0) return;
    Args a{};
    a.x = (const float*)d_in[0]; a.c = (const float*)d_in[1]; a.pos = (const int*)d_in[2]; a.ada_w = (const float*)d_in[3]; a.ada_b = (const float*)d_in[4];
    a.n1g = (const float*)d_in[5]; a.n2g = (const float*)d_in[6]; a.wqkv_a = (const float*)d_in[7]; a.qn_a = (const float*)d_in[8]; a.kn_a = (const float*)d_in[9];
    a.sinks_a = (const float*)d_in[10]; a.wo_a = (const float*)d_in[11]; a.wqkv_b = (const float*)d_in[12]; a.wo_b = (const float*)d_in[13];
    a.w_gate = (const float*)d_in[14]; a.w_up = (const float*)d_in[15]; a.w_down = (const float*)d_in[16];
    a.out = (float*)d_out; a.ws = (unsigned char*)d_ws;
#if MK_SPLIT
    for (int ph = 0; ph < NPHASE; ++ph) { a.ph_lo = ph; a.ph_hi = ph + 1; hipLaunchKernelGGL(mk_fwd, dim3(grid), dim3(512), LDS_BYTES, stream, a); }
#else
    a.ph_lo = 0; a.ph_hi = NPHASE;
    void* args[] = {&a};
    hipError_t e = hipLaunchCooperativeKernel((const void*)mk_fwd, dim3(grid), dim3(512), args, LDS_BYTES, stream);
    if (e != hipSuccess) fprintf(stderr, "kernel_launch: cooperative launch failed: %s (grid %d)\n", hipGetErrorString(e), grid);
#endif
}
```

```cpp
#include <hip/hip_runtime.h>
#include <hip/hip_cooperative_groups.h>
#include <cstdio>
#include <cstdint>
namespace cg = cooperative_groups;
namespace pg8 {
#define PG8_LAS __attribute__((address_space(3)))
typedef unsigned short bf16_t;
typedef short bf16x8 __attribute__((ext_vector_type(8)));
typedef float f32x4 __attribute__((ext_vector_type(4)));
typedef unsigned u32x4 __attribute__((ext_vector_type(4)));
constexpr int BM = 256, BK = 64, HALF = 128, HTB = HALF * BK * 2  , STAGE_BYTES = 8 * HTB, NXCD = 8, WGM = 8;

__host__ __device__ __forceinline__ int lds_byte(int r, int c) { const int st = (r >> 4) * 2 + (c >> 5), rr = r & 15, cc = c & 31, ob = rr * 64 + cc * 2; return st * 1024 + (ob ^ (((ob >> 9) & 1) << 5)); }
__host__ __device__ __forceinline__ void stage_rc(int b, int& R, int& C) { const int st = b / 1024, sb = b % 1024, swz = sb ^ (((sb >> 9) & 1) << 5); R = (st >> 1) * 16 + swz / 64; C = (st & 1) * 32 + (swz % 64) / 2; }
__host__ __device__ __forceinline__ int perm32(int rho) { const int n = rho >> 4, i = rho & 15; return 8 * (i >> 2) + 4 * n + (i & 3); }

struct Unit { int pm, pn; };
struct Gemm { const bf16_t* A; const bf16_t* Bt; int M, N, K; };

struct StaticOrder {
    int nM, nN, nwg, G, c;
    __host__ __device__ void init(int M, int N, int G_, int c_) { nM = M / BM; nN = N / BM; nwg = nM * nN; G = G_; c = c_; }
    __host__ __device__ bool next(int i, Unit& u) const {
        const long L = (long)i * G + c; if (L >= nwg) return false;
        int wgid = (int)L; { const int q = nwg / NXCD, r = nwg % NXCD, xcd = wgid % NXCD, off = wgid / NXCD; wgid = (xcd < r ? xcd * (q + 1) : r * (q + 1) + (xcd - r) * q) + off; }
        const int nig = WGM * nN, gid = wgid / nig, fm = gid * WGM, gsz = (nM - fm) < WGM ? (nM - fm) : WGM;
        u.pm = fm + ((wgid % nig) % gsz); u.pn = (wgid % nig) / gsz; return true;
    }
    __device__ __forceinline__ void a_ready(const Unit&) const {}
    __device__ __forceinline__ void done(const Unit&) const {}
};

__device__ __forceinline__ unsigned cvt_pk_bf16(float lo, float hi) { unsigned r; asm volatile("v_cvt_pk_bf16_f32 %0, %1, %2" : "=v"(r) : "v"(lo), "v"(hi)); return r; }
typedef float f32x2 __attribute__((ext_vector_type(2)));
template <class Epi, class Sched, bool ALIGN_EPI = false, bool SP2 = false>
__device__ __forceinline__ void gemm_phase(PG8_LAS unsigned char* lds, const Gemm g, const Sched& S, const Epi& E, const int tid) {
    const int wid = __builtin_amdgcn_readfirstlane(tid >> 6), lane = tid & 63, wr = wid >> 2, wc = wid & 3, fr = lane & 15, fq = lane >> 4;
    const int K = g.K, nt = K / BK;
    unsigned voffA[2], voffB[2];
#pragma unroll
    for (int i = 0; i < 2; ++i) { int R, C; stage_rc(tid * 16 + i * 8192, R, C); const int Rb = Epi::PERM ? ((R & ~31) + perm32(R & 31)) : R;
        voffA[i] = (unsigned)(R * K + C) * 2u; voffB[i] = (unsigned)(Rb * K + C) * 2u; }
    const size_t kstep = (size_t)(BK * 2);
    const size_t hstep = (size_t)HALF * K * 2;
    const size_t tstep = 2 * hstep;
    const unsigned ldsw = (unsigned)wid * 1024u;
    const int aoff = lds_byte(wr * 64 + fr, fq * 8), boff = lds_byte(wc * 32 + fr, fq * 8);
#define PG8_SA(b, h) (((b) * 2 + (h)) * HTB)
#define PG8_SB(b, h) ((4 + (b) * 2 + (h)) * HTB)
#define PG8_STAGE(bufoff, gbase, voff) do { _Pragma("unroll") for (int _i = 0; _i < 2; ++_i) \
        __builtin_amdgcn_global_load_lds((const unsigned*)((const char*)(gbase) + (voff)[_i]), (PG8_LAS unsigned*)(lds + (bufoff) + ldsw + _i * 8192), 16, 0, 0); } while (0)
#define PG8_LDA(dst, b, h) do { _Pragma("unroll") for (int m = 0; m < 4; ++m) _Pragma("unroll") for (int k = 0; k < 2; ++k) dst[m][k] = *(const PG8_LAS bf16x8*)(lds + PG8_SA(b, h) + aoff + m * 2048 + k * 1024); } while (0)
#define PG8_LDB(dst, b, h) do { _Pragma("unroll") for (int n = 0; n < 2; ++n) _Pragma("unroll") for (int k = 0; k < 2; ++k) dst[n][k] = *(const PG8_LAS bf16x8*)(lds + PG8_SB(b, h) + boff + n * 2048 + k * 1024); } while (0)
#define PG8_MMA(ai, bj, At, Bt) do { __builtin_amdgcn_s_setprio(1); _Pragma("unroll") for (int m = 0; m < 4; ++m) _Pragma("unroll") for (int n = 0; n < 2; ++n) _Pragma("unroll") for (int k = 0; k < 2; ++k) \
        acc[ai][bj][m][n] = __builtin_amdgcn_mfma_f32_16x16x32_bf16(Bt[n][k], At[m][k], acc[ai][bj][m][n], 0, 0, 0); __builtin_amdgcn_s_setprio(0); } while (0)
#define PG8_WAIT_V(n) asm volatile("s_waitcnt vmcnt(" #n ")" ::: "memory")
#define PG8_WAIT_L(n) asm volatile("s_waitcnt lgkmcnt(" #n ")" ::: "memory")
#define PG8_BAR __builtin_amdgcn_s_barrier()
#define PG8_SCHED __builtin_amdgcn_sched_barrier(0)
    Unit cur, nxt; int ui = 0;
    if (!S.next(0, cur)) return;
    f32x4 acc[2][2][4][2];
#pragma unroll
    for (int a = 0; a < 2; ++a)
#pragma unroll
        for (int b = 0; b < 2; ++b)
#pragma unroll
            for (int m = 0; m < 4; ++m)
#pragma unroll
                for (int n = 0; n < 2; ++n) acc[a][b][m][n] = (f32x4){0.f, 0.f, 0.f, 0.f};
    bf16x8 At[4][2], B0[2][2], B1[2][2];
    const char* cA = (const char*)g.A + (size_t)cur.pm * tstep; const char* cB = (const char*)g.Bt + (size_t)cur.pn * tstep;
    S.a_ready(cur);
    if constexpr (SP2) {
        PG8_STAGE(PG8_SB(0, 0), cB, voffB); PG8_STAGE(PG8_SB(0, 1), cB + hstep, voffB); PG8_STAGE(PG8_SA(0, 0), cA, voffA); PG8_STAGE(PG8_SA(0, 1), cA + hstep, voffA);
        if (wr == 1) PG8_BAR;
        PG8_WAIT_V(2); PG8_BAR;
        PG8_STAGE(PG8_SB(1, 0), cB + kstep, voffB); PG8_STAGE(PG8_SA(1, 0), cA + kstep, voffA); PG8_STAGE(PG8_SB(1, 1), cB + hstep + kstep, voffB);
        PG8_WAIT_V(6); PG8_BAR;
    } else {
        PG8_STAGE(PG8_SB(0, 0), cB, voffB); PG8_STAGE(PG8_SA(0, 0), cA, voffA); PG8_STAGE(PG8_SB(0, 1), cB + hstep, voffB); PG8_STAGE(PG8_SA(0, 1), cA + hstep, voffA);
        if (wr == 1) PG8_BAR;
        PG8_WAIT_V(4); PG8_BAR;
        PG8_STAGE(PG8_SB(1, 0), cB + kstep, voffB); PG8_STAGE(PG8_SA(1, 0), cA + kstep, voffA); PG8_STAGE(PG8_SB(1, 1), cB + hstep + kstep, voffB);
        PG8_WAIT_V(6); PG8_BAR;
    }
    for (;;) {
        const bool has_next = S.next(ui + 1, nxt);
        const char* nA = has_next ? (const char*)g.A + (size_t)nxt.pm * tstep : cA; const char* nB = has_next ? (const char*)g.Bt + (size_t)nxt.pn * tstep : cB;
        for (int t = 0; t < nt; t += 2) {
            const bool last = (t == nt - 2);
            const char* a1 = cA + (size_t)(t + 1) * kstep;
            const char* a2 = last ? nA : cA + (size_t)(t + 2) * kstep; const char* b2 = last ? nB : cB + (size_t)(t + 2) * kstep;
            const char* a3 = a2 + kstep; const char* b3 = b2 + kstep;
            if (last && has_next) S.a_ready(nxt);
            if constexpr (SP2) {
            PG8_LDB(B0, 0, 0); PG8_LDB(B1, 0, 1); PG8_SCHED; PG8_LDA(At, 0, 0); PG8_STAGE(PG8_SA(1, 1), a1 + hstep, voffA);
            PG8_WAIT_V(8); PG8_WAIT_L(0); PG8_BAR; PG8_MMA(0, 0, At, B0); PG8_MMA(0, 1, At, B1); PG8_BAR; PG8_SCHED;
            PG8_LDA(At, 0, 1); PG8_STAGE(PG8_SB(0, 0), b2, voffB); PG8_STAGE(PG8_SB(0, 1), b2 + hstep, voffB); PG8_STAGE(PG8_SA(0, 0), a2, voffA);
            PG8_WAIT_V(8); PG8_WAIT_L(0); PG8_BAR; PG8_MMA(1, 0, At, B0); PG8_MMA(1, 1, At, B1); PG8_BAR; PG8_SCHED;
            PG8_LDB(B0, 1, 0); PG8_LDB(B1, 1, 1); PG8_SCHED; PG8_LDA(At, 1, 0); PG8_STAGE(PG8_SA(0, 1), a2 + hstep, voffA);
            PG8_WAIT_V(8); PG8_WAIT_L(0); PG8_BAR; PG8_MMA(0, 0, At, B0); PG8_MMA(0, 1, At, B1); PG8_BAR; PG8_SCHED;
            PG8_LDA(At, 1, 1); PG8_STAGE(PG8_SB(1, 0), b3, voffB); PG8_STAGE(PG8_SB(1, 1), b3 + hstep, voffB); PG8_STAGE(PG8_SA(1, 0), a3, voffA);
            PG8_WAIT_V(8); PG8_WAIT_L(0); PG8_BAR; PG8_MMA(1, 0, At, B0); PG8_MMA(1, 1, At, B1); PG8_BAR; PG8_SCHED;
            } else {
            PG8_LDB(B0, 0, 0); PG8_SCHED; PG8_LDA(At, 0, 0); PG8_STAGE(PG8_SA(1, 1), a1 + hstep, voffA);
            PG8_WAIT_L(8); PG8_BAR; PG8_WAIT_L(0); PG8_MMA(0, 0, At, B0); PG8_BAR; PG8_SCHED;
            PG8_LDB(B1, 0, 1); PG8_STAGE(PG8_SB(0, 0), b2, voffB);
            PG8_BAR; PG8_WAIT_L(0); PG8_MMA(0, 1, At, B1); PG8_BAR;
            PG8_LDA(At, 0, 1); PG8_STAGE(PG8_SA(0, 0), a2, voffA);
            PG8_BAR; PG8_WAIT_L(0); PG8_MMA(1, 0, At, B0); PG8_BAR; PG8_SCHED;
            PG8_STAGE(PG8_SB(0, 1), b2 + hstep, voffB);
            PG8_WAIT_V(6); PG8_BAR; PG8_MMA(1, 1, At, B1); PG8_BAR;
            PG8_LDB(B0, 1, 0); PG8_SCHED; PG8_LDA(At, 1, 0); PG8_STAGE(PG8_SA(0, 1), a2 + hstep, voffA);
            PG8_WAIT_L(8); PG8_BAR; PG8_WAIT_L(0); PG8_MMA(0, 0, At, B0); PG8_BAR; PG8_SCHED;
            PG8_LDB(B1, 1, 1); PG8_STAGE(PG8_SB(1, 0), b3, voffB);
            PG8_BAR; PG8_WAIT_L(0); PG8_MMA(0, 1, At, B1); PG8_BAR;
            PG8_LDA(At, 1, 1); PG8_STAGE(PG8_SA(1, 0), a3, voffA);
            PG8_BAR; PG8_WAIT_L(0); PG8_MMA(1, 0, At, B0); PG8_BAR; PG8_SCHED;
            PG8_STAGE(PG8_SB(1, 1), b3 + hstep, voffB);
            PG8_WAIT_V(6); PG8_BAR; PG8_MMA(1, 1, At, B1); PG8_BAR;
            }
        }
        if constexpr (ALIGN_EPI) { if (wr == 0) PG8_BAR; }
        if constexpr (!Epi::AFTER_DRAIN) { E(acc, cur, wr, wc, fr, fq); S.done(cur); }
        if (!has_next) break;
#pragma unroll
        for (int a = 0; a < 2; ++a)
#pragma unroll
            for (int b = 0; b < 2; ++b)
#pragma unroll
                for (int m = 0; m < 4; ++m)
#pragma unroll
                    for (int n = 0; n < 2; ++n) acc[a][b][m][n] = (f32x4){0.f, 0.f, 0.f, 0.f};
        cur = nxt; cA = nA; cB = nB; ++ui;
        if constexpr (ALIGN_EPI) { if (wr == 1) PG8_BAR; }
    }
    PG8_WAIT_V(0);
    if constexpr (!ALIGN_EPI) { if (wr == 0) PG8_BAR; }
    PG8_BAR;
    if constexpr (Epi::AFTER_DRAIN) { E.fused(acc, cur, wr, wc, fr, fq, lds, wid, lane); S.done(cur); }
#undef PG8_SA
#undef PG8_SB
#undef PG8_STAGE
#undef PG8_LDA
#undef PG8_LDB
#undef PG8_MMA
#undef PG8_WAIT_V
#undef PG8_WAIT_L
#undef PG8_BAR
#undef PG8_SCHED
}
}

using pg8::bf16_t; using pg8::bf16x8; using pg8::f32x4; using pg8::u32x4; using pg8::cvt_pk_bf16; using pg8::Unit;
typedef float f32x16 __attribute__((ext_vector_type(16)));
typedef unsigned u32x2 __attribute__((ext_vector_type(2)));
#define LAS __attribute__((address_space(3)))

constexpr int DM = 1024, NB = 16, SEQ = 4096, NTOK = NB * SEQ, DEPTH = 4, HD = 64, DFF = 2816, NGU = 2 * DFF;
constexpr int NQKVA = 1280, NQKVB = 3072, NMOD = 6 * DM, SHW1_LD = 3072;
constexpr float EPS = 1e-6f;
constexpr int NPHASE = 2 + 5 * DEPTH;

constexpr size_t MiB = 1u << 20;
constexpr size_t WS_MOD = 0;
constexpr size_t WS_GS = 2 * MiB;
constexpr size_t WS_SHW1 = 3 * MiB;
constexpr size_t WS_SHW3 = 4 * MiB;
constexpr size_t WS_CS = 6 * MiB;
constexpr size_t WS_SSQ = 10 * MiB;
constexpr size_t WS_WQKVA = 16 * MiB;
constexpr size_t WS_WOA = 21 * MiB;
constexpr size_t WS_WQKB = 25 * MiB;
constexpr size_t WS_WVB = 33 * MiB;
constexpr size_t WS_WOB = 37 * MiB;
constexpr size_t WS_WGU = 41 * MiB;
constexpr size_t WS_WD = 85 * MiB;
constexpr size_t WS_XS = 112 * MiB;
constexpr size_t WS_Q = 240 * MiB;
constexpr size_t WS_K = 368 * MiB;
constexpr size_t WS_VT = 496 * MiB;
constexpr size_t WS_HID = 624 * MiB;
constexpr size_t WS_END = 976 * MiB;
constexpr size_t WS_CTL = 15 * MiB, CTL_BYTES = 8192;
constexpr int LDS_BYTES = 139264 + 1024;

struct Args {
    const float* x; const float* c; const int* pos; const float* ada_w; const float* ada_b; const float* n1g; const float* n2g;
    const float* wqkv_a; const float* qn_a; const float* kn_a; const float* sinks_a; const float* wo_a; const float* wqkv_b; const float* wo_b;
    const float* w_gate; const float* w_up; const float* w_down;
    float* out; unsigned char* ws; int ph_lo, ph_hi;
};

__constant__ float INVF[8] = {1.0f, 0.1939227432012558f, 0.03760603070259094f, 0.007292664609849453f, 0.0014142135623842478f, 0.00027424818836152554f, 5.318296098266728e-05f, 1.0313386155758053e-05f};

__device__ __forceinline__ float wave_sum(float v) {
#pragma unroll
    for (int o = 1; o < 64; o <<= 1) v += __shfl_xor(v, o);
    return v;
}
__device__ __forceinline__ float bf2f(unsigned short h) { return __uint_as_float((unsigned)h << 16); }
__device__ __forceinline__ float rstd_row(const float* ssq, int row) {
    const f32x4* p = (const f32x4*)(ssq + (size_t)row * 16);
    const f32x4 a = p[0], b = p[1], c = p[2], d = p[3];
    const float s = (((a.x + a.y) + (a.z + a.w)) + ((b.x + b.y) + (b.z + b.w))) + (((c.x + c.y) + (c.z + c.w)) + ((d.x + d.y) + (d.z + d.w)));
    return rsqrtf(s * (1.0f / DM) + EPS);
}
__device__ __forceinline__ u32x4 pack8(const f32x4& a, const f32x4& b) { u32x4 w; w.x = cvt_pk_bf16(a[0], a[1]); w.y = cvt_pk_bf16(a[2], a[3]); w.z = cvt_pk_bf16(b[0], b[1]); w.w = cvt_pk_bf16(b[2], b[3]); return w; }

struct EpiQKVA {
    static constexpr bool PERM = true, AFTER_DRAIN = false;
    bf16_t* Q; bf16_t* Kb; const LAS float* rsl; const float* shw; const float* qg; const float* kg; const float* cs;
    __device__ __forceinline__ void operator()(const f32x4 (&acc)[2][2][4][2], const Unit& u, int wr, int wc, int fr, int fq) const {
        if (u.pn == 4 && wc >= 2) return;
        const int b = u.pm >> 4; const bool isk = (u.pn == 4);
        const float* gain = isk ? kg : qg; const float qs = isk ? 1.0f : 0.125f;
        f32x4 bv[2][2], gv[2][2];
#pragma unroll
        for (int bj = 0; bj < 2; ++bj)
#pragma unroll
            for (int n = 0; n < 2; ++n) { bv[bj][n] = *(const f32x4*)(shw + b * SHW1_LD + u.pn * 256 + bj * 128 + wc * 32 + 8 * fq + 4 * n); gv[bj][n] = *(const f32x4*)(gain + 16 * fq + 8 * bj + 4 * n); }
#pragma unroll
        for (int ai = 0; ai < 2; ++ai)
#pragma unroll
            for (int m = 0; m < 4; ++m) {
                const int row = u.pm * 256 + ai * 128 + wr * 64 + m * 16 + fr;
                const float rs = rsl[((u.pm & 15) >> 2) * 256 + (row & 255)];
                f32x4 v[2][2]; float ss = 0.f;
#pragma unroll
                for (int bj = 0; bj < 2; ++bj)
#pragma unroll
                    for (int n = 0; n < 2; ++n) { v[bj][n] = acc[ai][bj][m][n] * rs + bv[bj][n]; const f32x4 t = v[bj][n]; ss += (t[0] * t[0] + t[1] * t[1]) + (t[2] * t[2] + t[3] * t[3]); }
                ss += __shfl_xor(ss, 16); ss += __shfl_xor(ss, 32);
                const float hr = rsqrtf(ss * (1.0f / HD) + EPS);
#pragma unroll
                for (int bj = 0; bj < 2; ++bj)
#pragma unroll
                    for (int n = 0; n < 2; ++n) v[bj][n] = v[bj][n] * hr * gv[bj][n];
                if (fq == 0) {
                    const f32x4* cp = (const f32x4*)(cs + (size_t)row * 16);
#pragma unroll
                    for (int n = 0; n < 2; ++n) { const f32x4 cc = cp[n], sn = cp[2 + n]; const f32x4 x1 = v[0][n], x2 = v[1][n]; v[0][n] = x1 * cc - x2 * sn; v[1][n] = x2 * cc + x1 * sn; }
                }
                bf16_t* dst = isk ? (Kb + (size_t)row * 128 + wc * 64) : (Q + (size_t)row * DM + (4 * u.pn + wc) * 64);
#pragma unroll
                for (int bj = 0; bj < 2; ++bj) *(u32x4*)(dst + 16 * fq + 8 * bj) = pack8(v[bj][0] * qs, v[bj][1] * qs);
            }
    }
};
struct EpiQKB {
    static constexpr bool PERM = true, AFTER_DRAIN = false;
    bf16_t* Q; bf16_t* Kb; const LAS float* rsl; const float* shw;
    __device__ __forceinline__ void operator()(const f32x4 (&acc)[2][2][4][2], const Unit& u, int wr, int wc, int fr, int fq) const {
        const int b = u.pm >> 4; const bool isk = (u.pn >= 4); const float qs = isk ? 1.0f : 0.125f * 1.4426950408889634f;
        bf16_t* base = (isk ? Kb : Q) + (u.pn & 3) * 256 + wc * 32 + 8 * fq;
        f32x4 bv[2][2];
#pragma unroll
        for (int bj = 0; bj < 2; ++bj)
#pragma unroll
            for (int n = 0; n < 2; ++n) bv[bj][n] = *(const f32x4*)(shw + b * SHW1_LD + u.pn * 256 + bj * 128 + wc * 32 + 8 * fq + 4 * n);
#pragma unroll
        for (int ai = 0; ai < 2; ++ai)
#pragma unroll
            for (int m = 0; m < 4; ++m) {
                const int row = u.pm * 256 + ai * 128 + wr * 64 + m * 16 + fr;
                const float rs = rsl[((u.pm & 15) >> 2) * 256 + (row & 255)] * qs;
#pragma unroll
                for (int bj = 0; bj < 2; ++bj) *(u32x4*)(base + (size_t)row * DM + bj * 128) = pack8(acc[ai][bj][m][0] * rs + bv[bj][0] * qs, acc[ai][bj][m][1] * rs + bv[bj][1] * qs);
            }
    }
};
template <bool MODE_A> struct EpiVT {
    static constexpr bool PERM = true, AFTER_DRAIN = false;
    bf16_t* VT; const LAS float* rsl; const float* shw;
    __device__ __forceinline__ void operator()(const f32x4 (&acc)[2][2][4][2], const Unit& u, int wr, int wc, int fr, int fq) const {
        if (MODE_A && wr == 0) return;
        const int lane = fr + 16 * fq; const int b = u.pn >> 4;
        const float myrs = rsl[((u.pn & 15) >> 2) * 256 + (lane >> 5) * 128 + wc * 32 + (lane & 31)];
        constexpr int NH = MODE_A ? 2 : 16;
#pragma unroll
        for (int bj = 0; bj < 2; ++bj) {
            float rs[8];
#pragma unroll
            for (int e = 0; e < 8; ++e) rs[e] = __shfl(myrs, bj * 32 + 8 * fq + e);
            const int t = (u.pn & 15) * 256 + bj * 128 + wc * 32 + 8 * fq;
#pragma unroll
            for (int ai = 0; ai < 2; ++ai)
#pragma unroll
                for (int m = 0; m < 4; ++m) {
                    int head, dim, bidx;
                    if (MODE_A) { const int rho = ai * 128 + wr * 64 + m * 16 + fr; head = ((rho >> 5) & 3) - 2; dim = 16 * ((rho & 31) >> 3) + 8 * ai + (rho & 7); bidx = 1024 + rho; }
                    else { const int vrow = u.pm * 256 + ai * 128 + wr * 64 + m * 16 + fr; head = vrow >> 6; dim = vrow & 63; bidx = 2048 + vrow; }
                    const float bias = shw[b * SHW1_LD + bidx];
                    const f32x4 a0 = acc[ai][bj][m][0], a1 = acc[ai][bj][m][1];
                    const f32x4 v0 = {a0[0] * rs[0] + bias, a0[1] * rs[1] + bias, a0[2] * rs[2] + bias, a0[3] * rs[3] + bias};
                    const f32x4 v1 = {a1[0] * rs[4] + bias, a1[1] * rs[5] + bias, a1[2] * rs[6] + bias, a1[3] * rs[7] + bias};
                    *(u32x4*)(VT + ((((size_t)(b * NH + head) * 64 + (t >> 6)) * 64 + dim) * 64 + (t & 63))) = pack8(v0, v1);
                }
        }
    }
};
struct EpiRes {
    static constexpr bool PERM = true, AFTER_DRAIN = false;
    const float* base; float* out; const float* gate; const float* gsn; bf16_t* xs; float* ssq; int has_next;
    __device__ __forceinline__ void operator()(const f32x4 (&acc)[2][2][4][2], const Unit& u, int wr, int wc, int fr, int fq) const {
        const int b = u.pm >> 4; const int col0 = u.pn * 256 + wc * 32 + 8 * fq;
        f32x4 gv[2][2], sv[2][2];
#pragma unroll
        for (int bj = 0; bj < 2; ++bj)
#pragma unroll
            for (int n = 0; n < 2; ++n) { gv[bj][n] = *(const f32x4*)(gate + b * NMOD + col0 + bj * 128 + n * 4); sv[bj][n] = has_next ? *(const f32x4*)(gsn + b * DM + col0 + bj * 128 + n * 4) : (f32x4){0.f, 0.f, 0.f, 0.f}; }
#pragma unroll
        for (int am = 0; am < 4; ++am) {
            const int ai = am >> 1;
            f32x4 xo[2][2][2];
#pragma unroll
            for (int mm = 0; mm < 2; ++mm) { const int m = (am & 1) * 2 + mm; const size_t off = (size_t)(u.pm * 256 + ai * 128 + wr * 64 + m * 16 + fr) * DM + col0;
#pragma unroll
                for (int bj = 0; bj < 2; ++bj)
#pragma unroll
                    for (int n = 0; n < 2; ++n) xo[mm][bj][n] = *(const f32x4*)(base + off + bj * 128 + n * 4); }
#pragma unroll
            for (int mm = 0; mm < 2; ++mm) {
                const int m = (am & 1) * 2 + mm;
                const int row = u.pm * 256 + ai * 128 + wr * 64 + m * 16 + fr; const size_t off = (size_t)row * DM + col0; float ss = 0.f;
#pragma unroll
                for (int bj = 0; bj < 2; ++bj) {
                    f32x4 xn[2];
#pragma unroll
                    for (int n = 0; n < 2; ++n) {
                        xn[n] = xo[mm][bj][n] + gv[bj][n] * acc[ai][bj][m][n];
                        *(f32x4*)(out + off + bj * 128 + n * 4) = xn[n];
                        ss += (xn[n][0] * xn[n][0] + xn[n][1] * xn[n][1]) + (xn[n][2] * xn[n][2] + xn[n][3] * xn[n][3]);
                    }
                    if (has_next) *(u32x4*)(xs + off + bj * 128) = pack8(xn[0] * sv[bj][0], xn[1] * sv[bj][1]);
                }
                ss += __shfl_xor(ss, 16); ss += __shfl_xor(ss, 32);
                if (has_next && fq == 0) ssq[(size_t)row * 16 + u.pn * 4 + wc] = ss;
            }
            asm volatile("" ::: "memory");
        }
    }
};
struct EpiSwiGLU {
    static constexpr bool PERM = true, AFTER_DRAIN = false;
    bf16_t* hid; const LAS float* rsl; const float* shw;
    __device__ __forceinline__ void operator()(const f32x4 (&acc)[2][2][4][2], const Unit& u, int wr, int wc, int fr, int fq) const {
        const int b = u.pm >> 4;
        f32x4 bg[2], bu[2];
#pragma unroll
        for (int n = 0; n < 2; ++n) { bg[n] = *(const f32x4*)(shw + b * NGU + u.pn * 256 + wc * 32 + 8 * fq + 4 * n); bu[n] = *(const f32x4*)(shw + b * NGU + u.pn * 256 + 128 + wc * 32 + 8 * fq + 4 * n); }
#pragma unroll
        for (int ai = 0; ai < 2; ++ai)
#pragma unroll
            for (int m = 0; m < 4; ++m) {
                const int row = u.pm * 256 + ai * 128 + wr * 64 + m * 16 + fr;
                const float rs = rsl[((u.pm & 15) >> 2) * 256 + (row & 255)];
                f32x4 h[2];
#pragma unroll
                for (int n = 0; n < 2; ++n) {
                    const f32x4 g = acc[ai][0][m][n] * rs + bg[n], up = acc[ai][1][m][n] * rs + bu[n];
                    f32x4 e; e[0] = __builtin_amdgcn_exp2f(-g[0]); e[1] = __builtin_amdgcn_exp2f(-g[1]); e[2] = __builtin_amdgcn_exp2f(-g[2]); e[3] = __builtin_amdgcn_exp2f(-g[3]);
                    const f32x4 d = e + 1.0f;
                    f32x4 r; r[0] = __builtin_amdgcn_rcpf(d[0]); r[1] = __builtin_amdgcn_rcpf(d[1]); r[2] = __builtin_amdgcn_rcpf(d[2]); r[3] = __builtin_amdgcn_rcpf(d[3]);
                    h[n] = (g * up) * r;
                }
                *(u32x4*)(hid + (size_t)row * DFF + u.pn * 128 + wc * 32 + 8 * fq) = pack8(h[0], h[1]);
            }
    }
};

__device__ __forceinline__ int dest_row(int kind, int n) {
    if (kind == 1) { const int hh = n >> 6, dim = n & 63; return 256 * (hh >> 2) + 128 * ((dim >> 3) & 1) + 32 * (hh & 3) + 8 * (dim >> 4) + (dim & 7); }
    if (kind == 3) return 256 * (n >> 7) + (n & 127);
    if (kind == 4) return 256 * (n >> 7) + 128 + (n & 127);
    return n;
}
__device__ __forceinline__ void transpose_item(const float* W, int K, int N, bf16_t* WT, int kind, int rowoff, LAS float* scr, int item, int lane) {
    const int nblk = N / 32, kb = item / nblk, nb = item % nblk, k0 = 64 * kb, n0 = 32 * nb;
    float tv[32];
    const float wsc = (kind == 3) ? 1.4426950408889634f : (kind == 4) ? 0.6931471805599453f : 1.0f;
#pragma unroll
    for (int i = 0; i < 32; ++i) tv[i] = W[(size_t)(k0 + 2 * i + (lane >> 5)) * N + n0 + (lane & 31)] * wsc;
#pragma unroll
    for (int i = 0; i < 32; ++i) scr[(2 * i + (lane >> 5)) * 33 + (lane & 31)] = tv[i];
    asm volatile("s_waitcnt lgkmcnt(0)" ::: "memory");
    const int c = lane & 7;
#pragma unroll
    for (int j = 0; j < 4; ++j) { const int n = (lane >> 3) + 8 * j; const LAS float* s = scr + (8 * c) * 33 + n;
        u32x4 o; o.x = cvt_pk_bf16(s[0 * 33], s[1 * 33]); o.y = cvt_pk_bf16(s[2 * 33], s[3 * 33]); o.z = cvt_pk_bf16(s[4 * 33], s[5 * 33]); o.w = cvt_pk_bf16(s[6 * 33], s[7 * 33]);
        *(u32x4*)(WT + (size_t)(dest_row(kind, n0 + n) + rowoff) * K + k0 + 8 * c) = o; }
    asm volatile("s_waitcnt lgkmcnt(0)" ::: "memory");
}

__device__ __forceinline__ void phase_p0(const Args& a, LAS unsigned char* lds, int tid, int lane, int wave) {
    unsigned char* ws = a.ws;
    { float* cs = (float*)(ws + WS_CS);
      for (int i = blockIdx.x * 512 + tid; i < NTOK * 8; i += gridDim.x * 512) {
          const int t = i >> 3, e = i & 7; const float ang = (float)a.pos[t] * INVF[e];
          const float n = rintf(ang * 0.15915494309189535f); float r = fmaf(-n, 6.2831854820251465f, ang); r = fmaf(-n, -1.7484556000744487e-07f, r);
          cs[(size_t)t * 16 + e] = __cosf(r); cs[(size_t)t * 16 + 8 + e] = __sinf(r); } }
    { LAS float* sc = (LAS float*)lds;
      LAS float* red = (LAS float*)(lds + 65536);
      for (int i = tid; i < NB * DM; i += 512) { const int b = i >> 10, k = i & 1023; const float v = a.c[i]; sc[k * 16 + b] = v / (1.0f + __expf(-v)); }
      __syncthreads();
      float* mod = (float*)(ws + WS_MOD);
      for (int item = blockIdx.x; item < DEPTH * (NMOD / 64); item += gridDim.x) {
          const int l = item / (NMOD / 64), n = (item % (NMOD / 64)) * 64 + lane;
          float acc[16];
#pragma unroll
          for (int b = 0; b < 16; ++b) acc[b] = 0.f;
          const float* wp = a.ada_w + ((size_t)l * DM + wave * 128) * NMOD + n;
#pragma unroll 16
          for (int k = 0; k < 128; ++k) { const float w = wp[(size_t)k * NMOD]; const LAS f32x4* s = (const LAS f32x4*)(sc + (wave * 128 + k) * 16);
#pragma unroll
              for (int q = 0; q < 4; ++q) { const f32x4 sv = s[q]; acc[4 * q + 0] += sv[0] * w; acc[4 * q + 1] += sv[1] * w; acc[4 * q + 2] += sv[2] * w; acc[4 * q + 3] += sv[3] * w; } }
#pragma unroll
          for (int b = 0; b < 16; ++b) red[(wave * 16 + b) * 64 + lane] = acc[b];
          __syncthreads();
          for (int o = tid; o < 16 * 64; o += 512) { const int b = o >> 6, nn = o & 63; float s = 0.f;
#pragma unroll
              for (int w = 0; w < 8; ++w) s += red[(w * 16 + b) * 64 + nn];
              const int col = (item % (NMOD / 64)) * 64 + nn; mod[((size_t)l * NB + b) * NMOD + col] = s + a.ada_b[l * NMOD + col]; }
          __syncthreads();
      } }
    __syncthreads();
    { LAS float* scr = (LAS float*)(lds + wave * 16384);
      const int gw = blockIdx.x * 8 + wave, NGW = gridDim.x * 8;
      constexpr int I_QA = 16 * 40, I_O = 16 * 32, I_QB = 16 * 96, I_G = 16 * 88, I_D = 44 * 32;
      constexpr int NIT = 2 * I_QA + 2 * I_O + 2 * I_QB + 2 * I_O + 4 * I_G + 4 * I_G + 4 * I_D;
      for (int it = gw; it < NIT; it += NGW) {
          int r = it;
          if (r < 2 * I_QA) { const int j = r / I_QA; transpose_item(a.wqkv_a + (size_t)j * DM * NQKVA, DM, NQKVA, (bf16_t*)(ws + WS_WQKVA) + (size_t)j * NQKVA * DM, 1, 0, scr, r % I_QA, lane); continue; } r -= 2 * I_QA;
          if (r < 2 * I_O) { const int j = r / I_O; transpose_item(a.wo_a + (size_t)j * DM * DM, DM, DM, (bf16_t*)(ws + WS_WOA) + (size_t)j * DM * DM, 0, 0, scr, r % I_O, lane); continue; } r -= 2 * I_O;
          if (r < 2 * I_QB) { const int j = r / I_QB, ii = r % I_QB; const bool isv = (ii % 96) >= 64;
              transpose_item(a.wqkv_b + (size_t)j * DM * NQKVB, DM, NQKVB, isv ? (bf16_t*)(ws + WS_WVB) + (size_t)j * DM * DM : (bf16_t*)(ws + WS_WQKB) + (size_t)j * 2048 * DM, 0, isv ? -2048 : 0, scr, ii, lane); continue; } r -= 2 * I_QB;
          if (r < 2 * I_O) { const int j = r / I_O; transpose_item(a.wo_b + (size_t)j * DM * DM, DM, DM, (bf16_t*)(ws + WS_WOB) + (size_t)j * DM * DM, 0, 0, scr, r % I_O, lane); continue; } r -= 2 * I_O;
          if (r < 4 * I_G) { const int l = r / I_G; transpose_item(a.w_gate + (size_t)l * DM * DFF, DM, DFF, (bf16_t*)(ws + WS_WGU) + (size_t)l * NGU * DM, 3, 0, scr, r % I_G, lane); continue; } r -= 4 * I_G;
          if (r < 4 * I_G) { const int l = r / I_G; transpose_item(a.w_up + (size_t)l * DM * DFF, DM, DFF, (bf16_t*)(ws + WS_WGU) + (size_t)l * NGU * DM, 4, 0, scr, r % I_G, lane); continue; } r -= 4 * I_G;
          { const int l = r / I_D; transpose_item(a.w_down + (size_t)l * DFF * DM, DFF, DM, (bf16_t*)(ws + WS_WD) + (size_t)l * DM * DFF, 0, 0, scr, r % I_D, lane); }
      } }
}

__device__ __forceinline__ void phase_p1(const Args& a, int tid, int lane, int wave) {
    unsigned char* ws = a.ws; const float* mod = (const float*)(ws + WS_MOD);
    { float* gs = (float*)(ws + WS_GS);
      for (int i = blockIdx.x * 512 + tid; i < DEPTH * 2 * NB * DM; i += gridDim.x * 512) {
          const int k = i & 1023, b = (i >> 10) & 15, s = (i >> 14) & 1, l = i >> 15;
          gs[i] = (s ? a.n2g : a.n1g)[l * DM + k] * (1.0f + mod[((size_t)l * NB + b) * NMOD + (s ? 4096 : 1024) + k]); } }
    const int gw = blockIdx.x * 8 + wave, NGW = gridDim.x * 8;
    { constexpr int RA = (NQKVA + NGU) / 16, RB = (NQKVB + NGU) / 16, RP = RA + RB;
      for (int r = gw; r < 2 * RP; r += NGW) {
          const int p = r / RP; int rr = r % RP; int l, n0, shoff, ld; const bf16_t* wbase; float* outp;
          if (rr < RA) { l = 2 * p;
              if (rr < NQKVA / 16) { n0 = rr * 16; wbase = (const bf16_t*)(ws + WS_WQKVA) + ((size_t)p * NQKVA + n0) * DM; shoff = 0; ld = SHW1_LD; outp = (float*)(ws + WS_SHW1) + (size_t)l * NB * SHW1_LD; }
              else { n0 = (rr - NQKVA / 16) * 16; wbase = (const bf16_t*)(ws + WS_WGU) + ((size_t)l * NGU + n0) * DM; shoff = 3072; ld = NGU; outp = (float*)(ws + WS_SHW3) + (size_t)l * NB * NGU; } }
          else { rr -= RA; l = 2 * p + 1;
              if (rr < NQKVB / 16) { n0 = rr * 16; wbase = (n0 < 2048) ? (const bf16_t*)(ws + WS_WQKB) + ((size_t)p * 2048 + n0) * DM : (const bf16_t*)(ws + WS_WVB) + ((size_t)p * DM + (n0 - 2048)) * DM; shoff = 0; ld = SHW1_LD; outp = (float*)(ws + WS_SHW1) + (size_t)l * NB * SHW1_LD; }
              else { n0 = (rr - NQKVB / 16) * 16; wbase = (const bf16_t*)(ws + WS_WGU) + ((size_t)l * NGU + n0) * DM; shoff = 3072; ld = NGU; outp = (float*)(ws + WS_SHW3) + (size_t)l * NB * NGU; } }
          const float* shp = mod + ((size_t)l * NB + (lane & 15)) * NMOD + shoff + 8 * (lane >> 4);
          const bf16_t* wp = wbase + (size_t)(lane & 15) * DM + 8 * (lane >> 4);
          f32x4 acc = {0.f, 0.f, 0.f, 0.f};
#pragma unroll 8
          for (int k0 = 0; k0 < DM; k0 += 32) {
              const bf16x8 wv = *(const bf16x8*)(wp + k0);
              const f32x4 s0 = *(const f32x4*)(shp + k0), s1 = *(const f32x4*)(shp + k0 + 4);
              u32x4 hi, lo;
              hi.x = cvt_pk_bf16(s0[0], s0[1]); hi.y = cvt_pk_bf16(s0[2], s0[3]); hi.z = cvt_pk_bf16(s1[0], s1[1]); hi.w = cvt_pk_bf16(s1[2], s1[3]);
              lo.x = cvt_pk_bf16(s0[0] - __uint_as_float(hi.x << 16), s0[1] - __uint_as_float(hi.x & 0xffff0000u)); lo.y = cvt_pk_bf16(s0[2] - __uint_as_float(hi.y << 16), s0[3] - __uint_as_float(hi.y & 0xffff0000u));
              lo.z = cvt_pk_bf16(s1[0] - __uint_as_float(hi.z << 16), s1[1] - __uint_as_float(hi.z & 0xffff0000u)); lo.w = cvt_pk_bf16(s1[2] - __uint_as_float(hi.w << 16), s1[3] - __uint_as_float(hi.w & 0xffff0000u));
              acc = __builtin_amdgcn_mfma_f32_16x16x32_bf16(__builtin_bit_cast(bf16x8, hi), wv, acc, 0, 0, 0);
              acc = __builtin_amdgcn_mfma_f32_16x16x32_bf16(__builtin_bit_cast(bf16x8, lo), wv, acc, 0, 0, 0);
          }
#pragma unroll
          for (int j = 0; j < 4; ++j) outp[(size_t)(4 * (lane >> 4) + j) * ld + n0 + (lane & 15)] = acc[j];
      } }
    { bf16_t* xs = (bf16_t*)(ws + WS_XS); float* ssq = (float*)(ws + WS_SSQ);
      for (int m0 = gw; m0 < NTOK; m0 += 2 * NGW) {
          f32x4 v[2][4];
#pragma unroll
          for (int q = 0; q < 2; ++q) { const f32x4* xr = (const f32x4*)(a.x + (size_t)(m0 + q * NGW) * DM) + lane;
#pragma unroll
              for (int j = 0; j < 4; ++j) v[q][j] = xr[64 * j]; }
#pragma unroll
          for (int q = 0; q < 2; ++q) { const int m = m0 + q * NGW; const int b = m >> 12; float s = 0.f;
#pragma unroll
              for (int j = 0; j < 4; ++j) { const f32x4 t = v[q][j]; s += (t[0] * t[0] + t[1] * t[1]) + (t[2] * t[2] + t[3] * t[3]);
                  const int col = 4 * lane + 256 * j; const f32x4 g = *(const f32x4*)(a.n1g + col), scv = *(const f32x4*)(mod + (size_t)b * NMOD + 1024 + col);
                  const f32x4 y = t * (g * (1.0f + scv)); u32x2 w; w.x = cvt_pk_bf16(y[0], y[1]); w.y = cvt_pk_bf16(y[2], y[3]); *(u32x2*)(xs + (size_t)m * DM + col) = w; }
              s = wave_sum(s); if (lane < 16) ssq[(size_t)m * 16 + lane] = (lane == 0) ? s : 0.f; } } }
}

__device__ __forceinline__ int pi32(int i) { return ((i >> 2) & 1) * 16 + (i >> 3) * 4 + (i & 3); }
#define MFMA32(a_, b_, c_) __builtin_amdgcn_mfma_f32_32x32x16_bf16((a_), (b_), (c_), 0, 0, 0)
__device__ __forceinline__ bf16x8 pack_p(const f32x16& p, int s2) {
    u32x4 w;
    if (s2 == 0) { w.x = cvt_pk_bf16(p[0], p[1]); w.y = cvt_pk_bf16(p[2], p[3]); w.z = cvt_pk_bf16(p[4], p[5]); w.w = cvt_pk_bf16(p[6], p[7]); }
    else { w.x = cvt_pk_bf16(p[8], p[9]); w.y = cvt_pk_bf16(p[10], p[11]); w.z = cvt_pk_bf16(p[12], p[13]); w.w = cvt_pk_bf16(p[14], p[15]); }
    return __builtin_bit_cast(bf16x8, w);
}
__device__ __forceinline__ void store_o(bf16_t* op, const f32x16& o0, const f32x16& o1, float sc) {
    u32x4 w;
    w.x = cvt_pk_bf16(o0[0] * sc, o0[1] * sc); w.y = cvt_pk_bf16(o0[2] * sc, o0[3] * sc); w.z = cvt_pk_bf16(o0[4] * sc, o0[5] * sc); w.w = cvt_pk_bf16(o0[6] * sc, o0[7] * sc); *(u32x4*)(op) = w;
    w.x = cvt_pk_bf16(o0[8] * sc, o0[9] * sc); w.y = cvt_pk_bf16(o0[10] * sc, o0[11] * sc); w.z = cvt_pk_bf16(o0[12] * sc, o0[13] * sc); w.w = cvt_pk_bf16(o0[14] * sc, o0[15] * sc); *(u32x4*)(op + 8) = w;
    w.x = cvt_pk_bf16(o1[0] * sc, o1[1] * sc); w.y = cvt_pk_bf16(o1[2] * sc, o1[3] * sc); w.z = cvt_pk_bf16(o1[4] * sc, o1[5] * sc); w.w = cvt_pk_bf16(o1[6] * sc, o1[7] * sc); *(u32x4*)(op + 32) = w;
    w.x = cvt_pk_bf16(o1[8] * sc, o1[9] * sc); w.y = cvt_pk_bf16(o1[10] * sc, o1[11] * sc); w.z = cvt_pk_bf16(o1[12] * sc, o1[13] * sc); w.w = cvt_pk_bf16(o1[14] * sc, o1[15] * sc); *(u32x4*)(op + 40) = w;
}
__device__ __forceinline__ int pinv32(int k) { return 8 * ((k >> 2) & 3) + 4 * (k >> 4) + (k & 3); }
constexpr int ATA_KB = 160 * 144, ATA_VB = 64 * 336, ATA_BUF = ATA_KB + ATA_VB;
__device__ __forceinline__ void attn_a_phase(const bf16_t* Q, const bf16_t* Kb, const bf16_t* VT, bf16_t* O, const float* sinks, int b, int rank, int gsz, int tid, LAS unsigned char* lds) {
    const int lane = tid & 63, wave = __builtin_amdgcn_readfirstlane(tid >> 6);
    const int ql = lane & 31, hi = lane >> 5;
    const float NEG = -__builtin_inff();
    const int ntask = 2 * 128;
    int koff[3], voff[3], krow[3], vd[3], vch[3];
#pragma unroll
    for (int r = 0; r < 3; ++r) { const int cid = tid + 512 * r; const int row = cid >> 3, c = cid & 7; krow[r] = row; koff[r] = (32 * (row >> 5) + pinv32(row & 31)) * 144 + c * 16 + ((cid & 7) * 0);
        const int d = cid / 20, ch = cid % 20; vd[r] = d; vch[r] = ch; voff[r] = ATA_KB + (32 * (d >> 5) + pinv32(d & 31)) * 336 + ch * 16; }
    const bool third = tid < 256;
    u32x4 gk[3], gv[3];
#define ATA_LOAD(TASK) do { const int blk_ = (TASK) & 127, kvh_ = (TASK) >> 7; const int ks_ = blk_ * 32 - 128; _Pragma("unroll") \
        for (int r = 0; r < 3; ++r) if (r < 2 || third) { int key_ = ks_ + krow[r]; key_ = key_ < 0 ? 0 : key_; gk[r] = *(const u32x4*)(Kb + ((size_t)b * SEQ + key_) * 128 + kvh_ * 64 + (tid & 7) * 8); \
            int kv_ = ks_ + 8 * vch[r]; kv_ = kv_ < 0 ? 0 : kv_; gv[r] = *(const u32x4*)(VT + ((((size_t)(b * 2 + kvh_) * 64 + (kv_ >> 6)) * 64 + vd[r]) * 64 + (kv_ & 63))); } } while (0)
#define ATA_STORE(BUF) do { LAS unsigned char* p_ = lds + (BUF) * ATA_BUF; _Pragma("unroll") \
        for (int r = 0; r < 3; ++r) if (r < 2 || third) { *(LAS u32x4*)(p_ + koff[r]) = gk[r]; *(LAS u32x4*)(p_ + voff[r]) = gv[r]; } } while (0)
    int it = 0;
    if (rank < ntask) { ATA_LOAD(rank); ATA_STORE(0); }
    bf16x8 qn[4];
    if (rank < ntask) { const bf16_t* qp0 = Q + ((size_t)b * SEQ + (rank & 127) * 32 + ql) * DM + ((rank >> 7) * 8 + wave) * 64 + hi * 8;
#pragma unroll
        for (int kk = 0; kk < 4; ++kk) qn[kk] = *(const bf16x8*)(qp0 + kk * 16); }
    for (int task = rank; task < ntask; task += gsz, ++it) {
        const int blk = task & 127, kvh = task >> 7, head = kvh * 8 + wave;
        const size_t row0 = (size_t)b * SEQ + blk * 32;
        bf16x8 qf[4];
#pragma unroll
        for (int kk = 0; kk < 4; ++kk) qf[kk] = qn[kk];
        const float sink = sinks[head];
        __syncthreads();
        const bool more = task + gsz < ntask;
        if (more) { ATA_LOAD(task + gsz);
            const int tn = task + gsz; const bf16_t* qpn = Q + ((size_t)b * SEQ + (tn & 127) * 32 + ql) * DM + ((tn >> 7) * 8 + wave) * 64 + hi * 8;
#pragma unroll
            for (int kk = 0; kk < 4; ++kk) qn[kk] = *(const bf16x8*)(qpn + kk * 16); }
        const LAS unsigned char* Kbuf = lds + (it & 1) * ATA_BUF; const LAS unsigned char* Vbuf = Kbuf + ATA_KB;
        f32x16 s[5];
#pragma unroll
        for (int i = 0; i < 5; ++i) {
            f32x16 z;
#pragma unroll
            for (int r = 0; r < 16; ++r) z[r] = 0.f;
#pragma unroll
            for (int kk = 0; kk < 4; ++kk) z = MFMA32(*(const LAS bf16x8*)(Kbuf + (32 * i + ql) * 144 + kk * 32 + hi * 16), qf[kk], z);
            const bool dead = (blk - 4 + i) < 0;
#pragma unroll
            for (int r = 0; r < 16; ++r) s[i][r] = dead ? NEG : z[r];
        }
#pragma unroll
        for (int r = 0; r < 16; ++r) { const int kl = 16 * hi + r; if (!(kl > ql)) s[0][r] = NEG; if (!(kl <= ql)) s[4][r] = NEG; }
        float mx = sink;
#pragma unroll
        for (int i = 0; i < 5; ++i)
#pragma unroll
            for (int r = 0; r < 16; ++r) mx = fmaxf(mx, s[i][r]);
        mx = fmaxf(mx, __shfl_xor(mx, 32));
        float den = 0.f;
#pragma unroll
        for (int i = 0; i < 5; ++i)
#pragma unroll
            for (int r = 0; r < 16; ++r) { const float p = __expf(s[i][r] - mx); s[i][r] = p; den += p; }
        den += __shfl_xor(den, 32); den += __expf(sink - mx);
        f32x16 o0, o1;
#pragma unroll
        for (int r = 0; r < 16; ++r) { o0[r] = 0.f; o1[r] = 0.f; }
#pragma unroll
        for (int i = 0; i < 5; ++i) {
            const bf16x8 pb0 = pack_p(s[i], 0), pb1 = pack_p(s[i], 1);
            const LAS unsigned char* vp = Vbuf + ql * 336 + 64 * i + 32 * hi;
            o0 = MFMA32(*(const LAS bf16x8*)(vp), pb0, o0); o0 = MFMA32(*(const LAS bf16x8*)(vp + 16), pb1, o0);
            o1 = MFMA32(*(const LAS bf16x8*)(vp + 32 * 336), pb0, o1); o1 = MFMA32(*(const LAS bf16x8*)(vp + 32 * 336 + 16), pb1, o1);
        }
        store_o(O + (row0 + ql) * DM + head * 64 + 16 * hi, o0, o1, 1.0f / den);
        if (more) ATA_STORE((it + 1) & 1);
    }
#undef ATA_LOAD
#undef ATA_STORE
    __syncthreads();
}
template <bool DIAG, int VS> __device__ __forceinline__ void sb_tile(const f32x16& z, float& carry, f32x16& o0, f32x16& o1, const LAS unsigned char* vp, int hi, int ql) {
    const bf16x8 v00 = *(const LAS bf16x8*)(vp), v01 = *(const LAS bf16x8*)(vp + 16), v10 = *(const LAS bf16x8*)(vp + 32 * VS), v11 = *(const LAS bf16x8*)(vp + 32 * VS + 16);
    f32x16 w; float run = 1.0f;
#pragma unroll
    for (int r = 15; r >= 0; --r) {
        float beta = __builtin_amdgcn_rcpf(1.0f + __builtin_amdgcn_exp2f(-z[r]));
        float om = 1.0f - beta;
        if (DIAG) { const bool valid = (16 * hi + r) < ql; beta = valid ? beta : 0.f; om = valid ? om : 1.0f; }
        w[r] = beta * run; run *= om;
    }
    const float other = __shfl_xor(run, 32);
    const float base = carry * (hi == 0 ? other : 1.0f);
    f32x16 p;
#pragma unroll
    for (int r = 0; r < 16; ++r) p[r] = w[r] * base;
    carry *= run * other;
    const bf16x8 pb0 = pack_p(p, 0), pb1 = pack_p(p, 1);
    o0 = MFMA32(v00, pb0, o0); o0 = MFMA32(v01, pb1, o0); o1 = MFMA32(v10, pb0, o1); o1 = MFMA32(v11, pb1, o1);
}
__device__ __forceinline__ void attn_b_phase(const bf16_t* Q, const bf16_t* Kb, const bf16_t* VT, bf16_t* O, int b, int gw, int NGW, int lane, LAS unsigned char* wl) {
    const int ql = lane & 31, hi = lane >> 5;
    LAS unsigned char* Kbuf = wl; LAS unsigned char* Vbuf = wl + 4608;
    const int kwoff = (lane & 7) * 16, vwoff = (lane & 3) * 16;
    const int kwbase = pinv32(lane >> 3) * 144 + kwoff, vwbase = (8 * ((lane >> 2) >> 2) + ((lane >> 2) & 3)) * 80 + vwoff;
#define KWROW(j) (kwbase + ((j) == 0 ? 0 : (j) == 1 ? 16 : (j) == 2 ? 4 : 20) * 144)
#define VWROW(j) (vwbase + ((j) == 0 ? 0 : (j) == 1 ? 4 : (j) == 2 ? 32 : 36) * 80)
    const int kroff = ql * 144 + hi * 16, vroff = ql * 80 + hi * 32;
    int it = 0;
    for (int task = gw; task < 16 * 64; task += NGW, ++it) {
        const int h = task >> 6; int jp = task & 63; if (it & 1) jp = 63 - jp;
        const int qlo = 2 * jp, qup = qlo + 1;
        const size_t row0 = (size_t)b * SEQ + qlo * 32;
        const bf16_t* qp = Q + (row0 + ql) * DM + h * 64 + hi * 8;
        bf16x8 qfl[4], qfu[4];
#pragma unroll
        for (int kk = 0; kk < 4; ++kk) { qfl[kk] = *(const bf16x8*)(qp + kk * 16); qfu[kk] = *(const bf16x8*)(qp + (size_t)32 * DM + kk * 16); }
#pragma unroll
        for (int kk = 0; kk < 4; ++kk) *(LAS bf16x8*)(wl + 9728 + kroff + kk * 32) = qfl[kk];
        const bf16_t* kg = Kb + ((size_t)b * SEQ + (lane >> 3)) * DM + h * 64 + (lane & 7) * 8;
        const bf16_t* vg = VT + ((size_t)(b * 16 + h) * 64) * 4096 + (size_t)(lane >> 2) * 64 + (lane & 3) * 8;
        f32x16 ol0, ol1, ou0, ou1;
#pragma unroll
        for (int r = 0; r < 16; ++r) { ol0[r] = 0.f; ol1[r] = 0.f; ou0[r] = 0.f; ou1[r] = 0.f; }
        float cl = 1.0f, cu = 1.0f; bool dl = false, du = false;
        u32x4 gk[4], gv[4];
        { const int key0 = qup * 32; const bf16_t* vb = vg + (size_t)(key0 >> 6) * 4096 + (key0 & 63);
#pragma unroll
          for (int j = 0; j < 4; ++j) { gk[j] = *(const u32x4*)(kg + (size_t)(key0 + 8 * j) * DM); gv[j] = *(const u32x4*)(vb + 16 * j * 64); } }
        for (int kt = qup; kt >= 0; --kt) {
#pragma unroll
            for (int j = 0; j < 4; ++j) { *(LAS u32x4*)(Kbuf + KWROW(j)) = gk[j]; *(LAS u32x4*)(Vbuf + VWROW(j)) = gv[j]; }
            if (kt > 0) { const int key0 = (kt - 1) * 32; const bf16_t* vb = vg + (size_t)(key0 >> 6) * 4096 + (key0 & 63);
#pragma unroll
                for (int j = 0; j < 4; ++j) { gk[j] = *(const u32x4*)(kg + (size_t)(key0 + 8 * j) * DM); gv[j] = *(const u32x4*)(vb + 16 * j * 64); } }
            if (!du) {
                f32x16 z;
#pragma unroll
                for (int r = 0; r < 16; ++r) z[r] = 0.f;
#pragma unroll
                for (int kk = 0; kk < 4; ++kk) z = MFMA32(*(const LAS bf16x8*)(Kbuf + kroff + kk * 32), qfu[kk], z);
                if (kt == qup) sb_tile<true, 80>(z, cu, ou0, ou1, Vbuf + vroff, hi, ql); else sb_tile<false, 80>(z, cu, ou0, ou1, Vbuf + vroff, hi, ql);
                if (__all(cu < 1e-37f)) du = true;
            }
            asm volatile("" ::: "memory");
            if (kt <= qlo && !dl) {
                f32x16 z;
#pragma unroll
                for (int r = 0; r < 16; ++r) z[r] = 0.f;
#pragma unroll
                for (int kk = 0; kk < 4; ++kk) z = MFMA32(*(const LAS bf16x8*)(Kbuf + kroff + kk * 32), *(const LAS bf16x8*)(wl + 9728 + kroff + kk * 32), z);
                if (kt == qlo) sb_tile<true, 80>(z, cl, ol0, ol1, Vbuf + vroff, hi, ql); else sb_tile<false, 80>(z, cl, ol0, ol1, Vbuf + vroff, hi, ql);
                if (__all(cl < 1e-37f)) dl = true;
            }
            if (du && dl) break;
        }
        store_o(O + (row0 + ql) * DM + h * 64 + 16 * hi, ol0, ol1, 1.0f);
        store_o(O + (row0 + 32 + ql) * DM + h * 64 + 16 * hi, ou0, ou1, 1.0f);
    }
#undef KWROW
#undef VWROW
}

__device__ __forceinline__ Args load_args() {
#if defined(__HIP_DEVICE_COMPILE__)
    const __attribute__((address_space(4))) Args* ap = (const __attribute__((address_space(4))) Args*)__builtin_amdgcn_kernarg_segment_ptr();
    asm volatile("" : "+s"(ap));
    return *ap;
#else
    return Args{};
#endif
}
struct GroupOrder {
    int nOther, b16, gsz, rank, swapped;
    __device__ __forceinline__ bool next(int i, Unit& u) const {
        int t, c;
        if (gsz == 16) {
            const int nfull = nOther >> 2, wt = nOther & 3;
            if (i < 4 * nfull) { t = 4 * (i & 3) + (rank & 3); c = 4 * (i >> 2) + (rank >> 2); }
            else { const int j = i - 4 * nfull; if (j >= wt) return false; const int h = (wt == 1) ? 16 : 8; if (wt == 3) return false; t = h * j + (rank % h); c = 4 * nfull + rank / h; if (t >= 16 || c >= nOther) return false; }
        } else { const int L = i * gsz + rank; if (L >= 16 * nOther) return false; t = L & 15; c = L >> 4; }
        t += b16; if (swapped) { u.pm = c; u.pn = t; } else { u.pm = t; u.pn = c; } return true; }
    __device__ __forceinline__ void a_ready(const Unit&) const {}
    __device__ __forceinline__ void done(const Unit&) const {}
};
__device__ __forceinline__ void counter_barrier(unsigned* cnt, unsigned target, bool same_l2) {
    asm volatile("s_waitcnt vmcnt(0) lgkmcnt(0)" ::: "memory");
    __syncthreads();
    if (threadIdx.x == 0) {
        if (!same_l2) __builtin_amdgcn_fence(__ATOMIC_RELEASE, "agent");
        asm volatile("s_waitcnt vmcnt(0)" ::: "memory");
        __hip_atomic_fetch_add(cnt, 1u, __ATOMIC_RELAXED, __HIP_MEMORY_SCOPE_AGENT);
        while (__hip_atomic_load(cnt, __ATOMIC_RELAXED, __HIP_MEMORY_SCOPE_AGENT) < target) __builtin_amdgcn_s_sleep(2);
        __builtin_amdgcn_fence(__ATOMIC_ACQUIRE, "agent");
        asm volatile("s_waitcnt vmcnt(0)" ::: "memory");
    }
    __syncthreads();
}

__global__ void __launch_bounds__(512, 2) mk_fwd(Args a0) {
    extern __shared__ __attribute__((aligned(16))) unsigned char lds_raw[];
    LAS unsigned char* lds = (LAS unsigned char*)lds_raw;
    cg::grid_group grid = cg::this_grid();
    const int wave0 = __builtin_amdgcn_readfirstlane(threadIdx.x >> 6);
    const int G = gridDim.x, GSZ = G >> 4;
    int grp, rank;
    if (G == 256) { const int xcd = blockIdx.x & 7, slot = blockIdx.x >> 3; grp = xcd * 2 + (slot >> 4); rank = slot & 15; } else { grp = blockIdx.x / GSZ; rank = blockIdx.x % GSZ; }
    int my_xcc = 0, my_ticket = 0; bool xlocal = false;
    { unsigned* ctl0 = (unsigned*)(load_args().ws + WS_CTL);
      LAS unsigned* sh = (LAS unsigned*)(lds + 136 * 1024);
      if (threadIdx.x == 0) { const unsigned x = (unsigned)__builtin_amdgcn_s_getreg((3 << 11) | 20) & 7u; sh[0] = x; sh[1] = __hip_atomic_fetch_add(ctl0 + 64 * (20 + x), 1u, __ATOMIC_RELAXED, __HIP_MEMORY_SCOPE_AGENT); }
      __syncthreads();
      my_xcc = __builtin_amdgcn_readfirstlane((int)sh[0]); my_ticket = __builtin_amdgcn_readfirstlane((int)sh[1]);
      __syncthreads(); }
    unsigned nbar = 0;
#ifdef PROBE_MASK
    unsigned long long tacc = 0ull, tprev = __builtin_amdgcn_s_memrealtime(); int prev_cls = -1;
#endif
    for (int ph = 0; ph < NPHASE; ++ph) {
        if (ph > 0) {
#ifdef PROBE_MASK
            const unsigned long long t0 = __builtin_amdgcn_s_memrealtime();
            if ((PROBE_MASK >> prev_cls) & 1) tacc += t0 - tprev;
#endif
            unsigned* ctl = (unsigned*)(load_args().ws + WS_CTL);
            if (ph == 1) { grid.sync();
                if (G == 256) { bool even = true;
#pragma unroll
                    for (int x = 0; x < 8; ++x) even = even && (__hip_atomic_load(ctl + 64 * (20 + x), __ATOMIC_RELAXED, __HIP_MEMORY_SCOPE_AGENT) == 32u);
                    if (even) { grp = my_xcc * 2 + (my_ticket >> 4); rank = my_ticket & 15; xlocal = true; } } }
            else if (ph == 2) counter_barrier(ctl, (unsigned)G, false);
            else { ++nbar; counter_barrier(ctl + 64 * (1 + grp), nbar * (unsigned)GSZ, xlocal); }
#ifdef PROBE_MASK
            unsigned long long t1 = __builtin_amdgcn_s_memrealtime();
            if (PROBE_MASK & 512) tacc += t1 - t0;
            if ((PROBE_MASK & 1024) && ph > 2) { ++nbar; counter_barrier(ctl + 64 * (1 + grp), nbar * (unsigned)GSZ, xlocal); const unsigned long long t2 = __builtin_amdgcn_s_memrealtime(); tacc += t2 - t1; t1 = t2; }
            tprev = t1;
#endif
        }
#ifdef PROBE_MASK
        if (ph == 0) prev_cls = 0; else if (ph == 1) prev_cls = 1; else { const int l_ = (ph - 2) / 5, sub_ = (ph - 2) % 5; prev_cls = (sub_ == 0) ? ((l_ & 1) ? 7 : 2) : (sub_ == 1) ? ((l_ & 1) ? 8 : 3) : (sub_ + 2); }
#endif
        int tid; asm volatile("v_mbcnt_lo_u32_b32 %0, -1, 0\n\tv_mbcnt_hi_u32_b32 %0, -1, %0" : "=v"(tid)); tid += wave0 * 64;
        const int lane = tid & 63, wave = __builtin_amdgcn_readfirstlane(tid >> 6);
        const Args a = load_args();
        unsigned char* ws = a.ws;
        bf16_t* XS = (bf16_t*)(ws + WS_XS); bf16_t* QB = (bf16_t*)(ws + WS_Q); bf16_t* KB = (bf16_t*)(ws + WS_K); bf16_t* VT = (bf16_t*)(ws + WS_VT); bf16_t* HID = (bf16_t*)(ws + WS_HID);
        float* SSQ = (float*)(ws + WS_SSQ); const float* MOD = (const float*)(ws + WS_MOD); const float* GS = (const float*)(ws + WS_GS);
        if (ph == 0) { phase_p0(a, lds, tid, lane, wave); continue; }
        if (ph == 1) { phase_p1(a, tid, lane, wave); continue; }
        const int l = (ph - 2) / 5, sub = (ph - 2) % 5, p = l >> 1; const bool isA = (l & 1) == 0;
        const float* shw1 = (const float*)(ws + WS_SHW1) + (size_t)l * NB * SHW1_LD;
        const int b16 = grp * 16;
        LAS float* rsl = (LAS float*)(lds + 131072);
        if (sub == 0 || sub == 3) {
            for (int i = tid; i < 1024; i += 512) rsl[i] = rstd_row(SSQ, (b16 + 4 * (i >> 8) + (rank & 3)) * 256 + (i & 255));
            __syncthreads();
        }
        if (sub == 0) {
            if (isA) {
                const bf16_t* W = (const bf16_t*)(ws + WS_WQKVA) + (size_t)p * NQKVA * DM;
                { pg8::Gemm g{XS, W, NTOK, NQKVA, DM}; GroupOrder S{NQKVA / 256, b16, GSZ, rank, 0};
                  EpiQKVA E{QB, KB, rsl, shw1, a.qn_a + p * HD, a.kn_a + p * HD, (const float*)(ws + WS_CS)};
                  pg8::gemm_phase<EpiQKVA, GroupOrder, true, true>(lds, g, S, E, tid); }
                { pg8::Gemm g{W + (size_t)1024 * DM, XS, 256, NTOK, DM}; GroupOrder S{1, b16, GSZ, rank, 1};
                  EpiVT<true> E{VT, rsl, shw1};
                  pg8::gemm_phase<EpiVT<true>, GroupOrder, true, true>(lds, g, S, E, tid); }
            } else {
                { pg8::Gemm g{XS, (const bf16_t*)(ws + WS_WQKB) + (size_t)p * 2048 * DM, NTOK, 2048, DM}; GroupOrder S{8, b16, GSZ, rank, 0};
                  EpiQKB E{QB, KB, rsl, shw1};
                  pg8::gemm_phase<EpiQKB, GroupOrder, true, true>(lds, g, S, E, tid); }
                { pg8::Gemm g{(const bf16_t*)(ws + WS_WVB) + (size_t)p * DM * DM, XS, DM, NTOK, DM}; GroupOrder S{4, b16, GSZ, rank, 1};
                  EpiVT<false> E{VT, rsl, shw1};
                  pg8::gemm_phase<EpiVT<false>, GroupOrder, true, true>(lds, g, S, E, tid); }
            }
        } else if (sub == 1) {
            if (isA) attn_a_phase(QB, KB, VT, QB, a.sinks_a + p * 16, grp, rank, GSZ, tid, lds);
            else attn_b_phase(QB, KB, VT, QB, grp, rank * 8 + wave, GSZ * 8, lane, lds + wave * 16384);
        } else if (sub == 2) {
            const bf16_t* W = isA ? (const bf16_t*)(ws + WS_WOA) + (size_t)p * DM * DM : (const bf16_t*)(ws + WS_WOB) + (size_t)p * DM * DM;
            pg8::Gemm g{QB, W, NTOK, DM, DM}; GroupOrder S{4, b16, GSZ, rank, 0};
            EpiRes E{l == 0 ? a.x : a.out, a.out, MOD + (size_t)l * NB * NMOD + 2048, GS + ((size_t)l * 2 + 1) * NB * DM, XS, SSQ, 1};
            pg8::gemm_phase<EpiRes, GroupOrder, true, true>(lds, g, S, E, tid);
        } else if (sub == 3) {
            pg8::Gemm g{XS, (const bf16_t*)(ws + WS_WGU) + (size_t)l * NGU * DM, NTOK, NGU, DM}; GroupOrder S{NGU / 256, b16, GSZ, rank, 0};
            EpiSwiGLU E{HID, rsl, (const float*)(ws + WS_SHW3) + (size_t)l * NB * NGU};
            pg8::gemm_phase<EpiSwiGLU, GroupOrder, true, true>(lds, g, S, E, tid);
        } else {
            pg8::Gemm g{HID, (const bf16_t*)(ws + WS_WD) + (size_t)l * DM * DFF, NTOK, DM, DFF}; GroupOrder S{4, b16, GSZ, rank, 0};
            EpiRes E{a.out, a.out, MOD + (size_t)l * NB * NMOD + 5120, GS + ((size_t)(l + 1) * 2) * NB * DM, XS, SSQ, l < DEPTH - 1 ? 1 : 0};
            pg8::gemm_phase<EpiRes, GroupOrder, true, true>(lds, g, S, E, tid);
        }
    }
#ifdef PROBE_MASK
    { const unsigned long long t0 = __builtin_amdgcn_s_memrealtime();
      if ((PROBE_MASK >> prev_cls) & 1) tacc += t0 - tprev;
      if (blockIdx.x == 0) { while (__builtin_amdgcn_s_memrealtime() - t0 < tacc) __builtin_amdgcn_s_sleep(8); } }
#endif
}

extern "C" void kernel_launch(void* const* d_in, const int* in_sizes, int n_in, void* d_out, int out_size, void* d_ws, size_t ws_size, hipStream_t stream) {
    static int grid = 0;
    if (grid == 0) {
        if (n_in != 17 || in_sizes[0] != NTOK * DM || out_size != NTOK * DM || ws_size < WS_END) { fprintf(stderr, "kernel_launch: unexpected shapes / workspace (n_in %d, ws %zu, need %zu)\n", n_in, ws_size, (size_t)WS_END); grid = -1; return; }
        int dev = 0, cus = 0, per_cu = 0;
        (void)hipGetDevice(&dev); (void)hipDeviceGetAttribute(&cus, hipDeviceAttributeMultiprocessorCount, dev);
        if (hipFuncSetAttribute((const void*)mk_fwd, hipFuncAttributeMaxDynamicSharedMemorySize, LDS_BYTES) != hipSuccess) { fprintf(stderr, "kernel_launch: hipFuncSetAttribute failed\n"); grid = -1; return; }
        if (hipOccupancyMaxActiveBlocksPerMultiprocessor(&per_cu, (const void*)mk_fwd, 512, LDS_BYTES) != hipSuccess || per_cu < 1) { fprintf(stderr, "kernel_launch: occupancy query says %d\n", per_cu); }
        (void)hipGetLastError();
        grid = 256;
        if (cus < 256) { fprintf(stderr, "kernel_launch: %d CUs, this kernel needs 256 co-resident workgroups\n", cus); grid = -1; return; }
    }
    if (grid < 0) return;
    if (hipMemsetAsync((char*)d_ws + WS_CTL, 0, CTL_BYTES, stream) != hipSuccess) { fprintf(stderr, "kernel_launch: memset failed\n"); return; }
    Args a{};
    a.x = (const float*)d_in[0]; a.c = (const float*)d_in[1]; a.pos = (const int*)d_in[2]; a.ada_w = (const float*)d_in[3]; a.ada_b = (const float*)d_in[4];
    a.n1g = (const float*)d_in[5]; a.n2g = (const float*)d_in[6]; a.wqkv_a = (const float*)d_in[7]; a.qn_a = (const float*)d_in[8]; a.kn_a = (const float*)d_in[9];
    a.sinks_a = (const float*)d_in[10]; a.wo_a = (const float*)d_in[11]; a.wqkv_b = (const float*)d_in[12]; a.wo_b = (const float*)d_in[13];
    a.w_gate = (const float*)d_in[14]; a.w_up = (const float*)d_in[15]; a.w_down = (const float*)d_in[16];
    a.out = (float*)d_out; a.ws = (unsigned char*)d_ws; a.ph_lo = 0; a.ph_hi = NPHASE;
    void* args[] = {&a};
    hipError_t e = hipLaunchCooperativeKernel((const void*)mk_fwd, dim3(grid), dim3(512), args, LDS_BYTES, stream);
    if (e != hipSuccess) fprintf(stderr, "kernel_launch: cooperative launch failed: %s (grid %d)\n", hipGetErrorString(e), grid);
}
```

```cpp
#include <hip/hip_runtime.h>
#include <hip/hip_cooperative_groups.h>
#include <cstdio>
#include <cstdint>
namespace cg = cooperative_groups;
namespace pg8 {
#define PG8_LAS __attribute__((address_space(3)))
typedef unsigned short bf16_t;
typedef short bf16x8 __attribute__((ext_vector_type(8)));
typedef float f32x4 __attribute__((ext_vector_type(4)));
typedef unsigned u32x4 __attribute__((ext_vector_type(4)));
constexpr int BM = 256, BK = 64, HALF = 128, HTB = HALF * BK * 2  , STAGE_BYTES = 8 * HTB, NXCD = 8, WGM = 8;

__host__ __device__ __forceinline__ int lds_byte(int r, int c) { const int st = (r >> 4) * 2 + (c >> 5), rr = r & 15, cc = c & 31, ob = rr * 64 + cc * 2; return st * 1024 + (ob ^ (((ob >> 9) & 1) << 5)); }
__host__ __device__ __forceinline__ void stage_rc(int b, int& R, int& C) { const int st = b / 1024, sb = b % 1024, swz = sb ^ (((sb >> 9) & 1) << 5); R = (st >> 1) * 16 + swz / 64; C = (st & 1) * 32 + (swz % 64) / 2; }
__host__ __device__ __forceinline__ int perm32(int rho) { const int n = rho >> 4, i = rho & 15; return 8 * (i >> 2) + 4 * n + (i & 3); }

struct Unit { int pm, pn; };
struct Gemm { const bf16_t* A; const bf16_t* Bt; int M, N, K; };

struct StaticOrder {
    int nM, nN, nwg, G, c;
    __host__ __device__ void init(int M, int N, int G_, int c_) { nM = M / BM; nN = N / BM; nwg = nM * nN; G = G_; c = c_; }
    __host__ __device__ bool next(int i, Unit& u) const {
        const long L = (long)i * G + c; if (L >= nwg) return false;
        int wgid = (int)L; { const int q = nwg / NXCD, r = nwg % NXCD, xcd = wgid % NXCD, off = wgid / NXCD; wgid = (xcd < r ? xcd * (q + 1) : r * (q + 1) + (xcd - r) * q) + off; }
        const int nig = WGM * nN, gid = wgid / nig, fm = gid * WGM, gsz = (nM - fm) < WGM ? (nM - fm) : WGM;
        u.pm = fm + ((wgid % nig) % gsz); u.pn = (wgid % nig) / gsz; return true;
    }
    __device__ __forceinline__ void a_ready(const Unit&) const {}
    __device__ __forceinline__ void done(const Unit&) const {}
};

__device__ __forceinline__ unsigned cvt_pk_bf16(float lo, float hi) { unsigned r; asm volatile("v_cvt_pk_bf16_f32 %0, %1, %2" : "=v"(r) : "v"(lo), "v"(hi)); return r; }
typedef float f32x2 __attribute__((ext_vector_type(2)));
template <class Epi, class Sched, bool ALIGN_EPI = false, bool SP2 = false>
__device__ __forceinline__ void gemm_phase(PG8_LAS unsigned char* lds, const Gemm g, const Sched& S, const Epi& E, const int tid) {
    const int wid = __builtin_amdgcn_readfirstlane(tid >> 6), lane = tid & 63, wr = wid >> 2, wc = wid & 3, fr = lane & 15, fq = lane >> 4;
    const int K = g.K, nt = K / BK;
    unsigned voffA[2], voffB[2];
#pragma unroll
    for (int i = 0; i < 2; ++i) { int R, C; stage_rc(tid * 16 + i * 8192, R, C); const int Rb = Epi::PERM ? ((R & ~31) + perm32(R & 31)) : R;
        voffA[i] = (unsigned)(R * K + C) * 2u; voffB[i] = (unsigned)(Rb * K + C) * 2u; }
    const size_t kstep = (size_t)(BK * 2);
    const size_t hstep = (size_t)HALF * K * 2;
    const size_t tstep = 2 * hstep;
    const unsigned ldsw = (unsigned)wid * 1024u;
    const int aoff = lds_byte(wr * 64 + fr, fq * 8), boff = lds_byte(wc * 32 + fr, fq * 8);
#define PG8_SA(b, h) (((b) * 2 + (h)) * HTB)
#define PG8_SB(b, h) ((4 + (b) * 2 + (h)) * HTB)
#define PG8_STAGE(bufoff, gbase, voff) do { _Pragma("unroll") for (int _i = 0; _i < 2; ++_i) \
        __builtin_amdgcn_global_load_lds((const unsigned*)((const char*)(gbase) + (voff)[_i]), (PG8_LAS unsigned*)(lds + (bufoff) + ldsw + _i * 8192), 16, 0, 0); } while (0)
#define PG8_LDA(dst, b, h) do { _Pragma("unroll") for (int m = 0; m < 4; ++m) _Pragma("unroll") for (int k = 0; k < 2; ++k) dst[m][k] = *(const PG8_LAS bf16x8*)(lds + PG8_SA(b, h) + aoff + m * 2048 + k * 1024); } while (0)
#define PG8_LDB(dst, b, h) do { _Pragma("unroll") for (int n = 0; n < 2; ++n) _Pragma("unroll") for (int k = 0; k < 2; ++k) dst[n][k] = *(const PG8_LAS bf16x8*)(lds + PG8_SB(b, h) + boff + n * 2048 + k * 1024); } while (0)
#define PG8_MMA(ai, bj, At, Bt) do { __builtin_amdgcn_s_setprio(1); _Pragma("unroll") for (int m = 0; m < 4; ++m) _Pragma("unroll") for (int n = 0; n < 2; ++n) _Pragma("unroll") for (int k = 0; k < 2; ++k) \
        acc[ai][bj][m][n] = __builtin_amdgcn_mfma_f32_16x16x32_bf16(Bt[n][k], At[m][k], acc[ai][bj][m][n], 0, 0, 0); __builtin_amdgcn_s_setprio(0); } while (0)
#define PG8_WAIT_V(n) asm volatile("s_waitcnt vmcnt(" #n ")" ::: "memory")
#define PG8_WAIT_L(n) asm volatile("s_waitcnt lgkmcnt(" #n ")" ::: "memory")
#define PG8_BAR __builtin_amdgcn_s_barrier()
#define PG8_SCHED __builtin_amdgcn_sched_barrier(0)
    Unit cur, nxt; int ui = 0;
    if (!S.next(0, cur)) return;
    f32x4 acc[2][2][4][2];
#pragma unroll
    for (int a = 0; a < 2; ++a)
#pragma unroll
        for (int b = 0; b < 2; ++b)
#pragma unroll
            for (int m = 0; m < 4; ++m)
#pragma unroll
                for (int n = 0; n < 2; ++n) acc[a][b][m][n] = (f32x4){0.f, 0.f, 0.f, 0.f};
    bf16x8 At[4][2], B0[2][2], B1[2][2];
    const char* cA = (const char*)g.A + (size_t)cur.pm * tstep; const char* cB = (const char*)g.Bt + (size_t)cur.pn * tstep;
    S.a_ready(cur);
    if constexpr (SP2) {
        PG8_STAGE(PG8_SB(0, 0), cB, voffB); PG8_STAGE(PG8_SB(0, 1), cB + hstep, voffB); PG8_STAGE(PG8_SA(0, 0), cA, voffA); PG8_STAGE(PG8_SA(0, 1), cA + hstep, voffA);
        if (wr == 1) PG8_BAR;
        PG8_WAIT_V(2); PG8_BAR;
        PG8_STAGE(PG8_SB(1, 0), cB + kstep, voffB); PG8_STAGE(PG8_SA(1, 0), cA + kstep, voffA); PG8_STAGE(PG8_SB(1, 1), cB + hstep + kstep, voffB);
        PG8_WAIT_V(6); PG8_BAR;
    } else {
        PG8_STAGE(PG8_SB(0, 0), cB, voffB); PG8_STAGE(PG8_SA(0, 0), cA, voffA); PG8_STAGE(PG8_SB(0, 1), cB + hstep, voffB); PG8_STAGE(PG8_SA(0, 1), cA + hstep, voffA);
        if (wr == 1) PG8_BAR;
        PG8_WAIT_V(4); PG8_BAR;
        PG8_STAGE(PG8_SB(1, 0), cB + kstep, voffB); PG8_STAGE(PG8_SA(1, 0), cA + kstep, voffA); PG8_STAGE(PG8_SB(1, 1), cB + hstep + kstep, voffB);
        PG8_WAIT_V(6); PG8_BAR;
    }
    for (;;) {
        const bool has_next = S.next(ui + 1, nxt);
        const char* nA = has_next ? (const char*)g.A + (size_t)nxt.pm * tstep : cA; const char* nB = has_next ? (const char*)g.Bt + (size_t)nxt.pn * tstep : cB;
        for (int t = 0; t < nt; t += 2) {
            const bool last = (t == nt - 2);
            const char* a1 = cA + (size_t)(t + 1) * kstep;
            const char* a2 = last ? nA : cA + (size_t)(t + 2) * kstep; const char* b2 = last ? nB : cB + (size_t)(t + 2) * kstep;
            const char* a3 = a2 + kstep; const char* b3 = b2 + kstep;
            if (last && has_next) S.a_ready(nxt);
            if constexpr (SP2) {
            PG8_LDB(B0, 0, 0); PG8_LDB(B1, 0, 1); PG8_SCHED; PG8_LDA(At, 0, 0); PG8_STAGE(PG8_SA(1, 1), a1 + hstep, voffA);
            PG8_WAIT_V(8); PG8_WAIT_L(0); PG8_BAR; PG8_MMA(0, 0, At, B0); PG8_MMA(0, 1, At, B1); PG8_BAR; PG8_SCHED;
            PG8_LDA(At, 0, 1); PG8_STAGE(PG8_SB(0, 0), b2, voffB); PG8_STAGE(PG8_SB(0, 1), b2 + hstep, voffB); PG8_STAGE(PG8_SA(0, 0), a2, voffA);
            PG8_WAIT_V(8); PG8_WAIT_L(0); PG8_BAR; PG8_MMA(1, 0, At, B0); PG8_MMA(1, 1, At, B1); PG8_BAR; PG8_SCHED;
            PG8_LDB(B0, 1, 0); PG8_LDB(B1, 1, 1); PG8_SCHED; PG8_LDA(At, 1, 0); PG8_STAGE(PG8_SA(0, 1), a2 + hstep, voffA);
            PG8_WAIT_V(8); PG8_WAIT_L(0); PG8_BAR; PG8_MMA(0, 0, At, B0); PG8_MMA(0, 1, At, B1); PG8_BAR; PG8_SCHED;
            PG8_LDA(At, 1, 1); PG8_STAGE(PG8_SB(1, 0), b3, voffB); PG8_STAGE(PG8_SB(1, 1), b3 + hstep, voffB); PG8_STAGE(PG8_SA(1, 0), a3, voffA);
            PG8_WAIT_V(8); PG8_WAIT_L(0); PG8_BAR; PG8_MMA(1, 0, At, B0); PG8_MMA(1, 1, At, B1); PG8_BAR; PG8_SCHED;
            } else {
            PG8_LDB(B0, 0, 0); PG8_SCHED; PG8_LDA(At, 0, 0); PG8_STAGE(PG8_SA(1, 1), a1 + hstep, voffA);
            PG8_WAIT_L(8); PG8_BAR; PG8_WAIT_L(0); PG8_MMA(0, 0, At, B0); PG8_BAR; PG8_SCHED;
            PG8_LDB(B1, 0, 1); PG8_STAGE(PG8_SB(0, 0), b2, voffB);
            PG8_BAR; PG8_WAIT_L(0); PG8_MMA(0, 1, At, B1); PG8_BAR;
            PG8_LDA(At, 0, 1); PG8_STAGE(PG8_SA(0, 0), a2, voffA);
            PG8_BAR; PG8_WAIT_L(0); PG8_MMA(1, 0, At, B0); PG8_BAR; PG8_SCHED;
            PG8_STAGE(PG8_SB(0, 1), b2 + hstep, voffB);
            PG8_WAIT_V(6); PG8_BAR; PG8_MMA(1, 1, At, B1); PG8_BAR;
            PG8_LDB(B0, 1, 0); PG8_SCHED; PG8_LDA(At, 1, 0); PG8_STAGE(PG8_SA(0, 1), a2 + hstep, voffA);
            PG8_WAIT_L(8); PG8_BAR; PG8_WAIT_L(0); PG8_MMA(0, 0, At, B0); PG8_BAR; PG8_SCHED;
            PG8_LDB(B1, 1, 1); PG8_STAGE(PG8_SB(1, 0), b3, voffB);
            PG8_BAR; PG8_WAIT_L(0); PG8_MMA(0, 1, At, B1); PG8_BAR;
            PG8_LDA(At, 1, 1); PG8_STAGE(PG8_SA(1, 0), a3, voffA);
            PG8_BAR; PG8_WAIT_L(0); PG8_MMA(1, 0, At, B0); PG8_BAR; PG8_SCHED;
            PG8_STAGE(PG8_SB(1, 1), b3 + hstep, voffB);
            PG8_WAIT_V(6); PG8_BAR; PG8_MMA(1, 1, At, B1); PG8_BAR;
            }
        }
        if constexpr (ALIGN_EPI) { if (wr == 0) PG8_BAR; }
        if constexpr (!Epi::AFTER_DRAIN) { E(acc, cur, wr, wc, fr, fq); S.done(cur); }
        if (!has_next) break;
#pragma unroll
        for (int a = 0; a < 2; ++a)
#pragma unroll
            for (int b = 0; b < 2; ++b)
#pragma unroll
                for (int m = 0; m < 4; ++m)
#pragma unroll
                    for (int n = 0; n < 2; ++n) acc[a][b][m][n] = (f32x4){0.f, 0.f, 0.f, 0.f};
        cur = nxt; cA = nA; cB = nB; ++ui;
        if constexpr (ALIGN_EPI) { if (wr == 1) PG8_BAR; }
    }
    PG8_WAIT_V(0);
    if constexpr (!ALIGN_EPI) { if (wr == 0) PG8_BAR; }
    PG8_BAR;
    if constexpr (Epi::AFTER_DRAIN) { E.fused(acc, cur, wr, wc, fr, fq, lds, wid, lane); S.done(cur); }
#undef PG8_SA
#undef PG8_SB
#undef PG8_STAGE
#undef PG8_LDA
#undef PG8_LDB
#undef PG8_MMA
#undef PG8_WAIT_V
#undef PG8_WAIT_L
#undef PG8_BAR
#undef PG8_SCHED
}
}

using pg8::bf16_t; using pg8::bf16x8; using pg8::f32x4; using pg8::u32x4; using pg8::cvt_pk_bf16; using pg8::Unit;
typedef float f32x16 __attribute__((ext_vector_type(16)));
typedef unsigned u32x2 __attribute__((ext_vector_type(2)));
#define LAS __attribute__((address_space(3)))

constexpr int DM = 1024, NB = 16, SEQ = 4096, NTOK = NB * SEQ, DEPTH = 4, HD = 64, DFF = 2816, NGU = 2 * DFF;
constexpr int NQKVA = 1280, NQKVB = 3072, NMOD = 6 * DM, SHW1_LD = 3072;
constexpr float EPS = 1e-6f;
constexpr int NPHASE = 2 + 5 * DEPTH;

constexpr size_t MiB = 1u << 20;
constexpr size_t WS_MOD = 0;
constexpr size_t WS_GS = 2 * MiB;
constexpr size_t WS_SHW1 = 3 * MiB;
constexpr size_t WS_SHW3 = 4 * MiB;
constexpr size_t WS_CS = 6 * MiB;
constexpr size_t WS_SSQ = 10 * MiB;
constexpr size_t WS_WQKVA = 16 * MiB;
constexpr size_t WS_WOA = 21 * MiB;
constexpr size_t WS_WQKB = 25 * MiB;
constexpr size_t WS_WVB = 33 * MiB;
constexpr size_t WS_WOB = 37 * MiB;
constexpr size_t WS_WGU = 41 * MiB;
constexpr size_t WS_WD = 85 * MiB;
constexpr size_t WS_XS = 112 * MiB;
constexpr size_t WS_Q = 240 * MiB;
constexpr size_t WS_K = 368 * MiB;
constexpr size_t WS_VT = 496 * MiB;
constexpr size_t WS_HID = 624 * MiB;
constexpr size_t WS_END = 976 * MiB;
constexpr size_t WS_CTL = 15 * MiB, CTL_BYTES = 8192;
constexpr int LDS_BYTES = 139264 + 1024;

struct Args {
    const float* x; const float* c; const int* pos; const float* ada_w; const float* ada_b; const float* n1g; const float* n2g;
    const float* wqkv_a; const float* qn_a; const float* kn_a; const float* sinks_a; const float* wo_a; const float* wqkv_b; const float* wo_b;
    const float* w_gate; const float* w_up; const float* w_down;
    float* out; unsigned char* ws; int ph_lo, ph_hi;
};

__constant__ float INVF[8] = {1.0f, 0.1939227432012558f, 0.03760603070259094f, 0.007292664609849453f, 0.0014142135623842478f, 0.00027424818836152554f, 5.318296098266728e-05f, 1.0313386155758053e-05f};

__device__ __forceinline__ float wave_sum(float v) {
#pragma unroll
    for (int o = 1; o < 64; o <<= 1) v += __shfl_xor(v, o);
    return v;
}
__device__ __forceinline__ float bf2f(unsigned short h) { return __uint_as_float((unsigned)h << 16); }
__device__ __forceinline__ float rstd_row(const float* ssq, int row) {
    const f32x4* p = (const f32x4*)(ssq + (size_t)row * 16);
    const f32x4 a = p[0], b = p[1], c = p[2], d = p[3];
    const float s = (((a.x + a.y) + (a.z + a.w)) + ((b.x + b.y) + (b.z + b.w))) + (((c.x + c.y) + (c.z + c.w)) + ((d.x + d.y) + (d.z + d.w)));
    return rsqrtf(s * (1.0f / DM) + EPS);
}
__device__ __forceinline__ u32x4 pack8(const f32x4& a, const f32x4& b) { u32x4 w; w.x = cvt_pk_bf16(a[0], a[1]); w.y = cvt_pk_bf16(a[2], a[3]); w.z = cvt_pk_bf16(b[0], b[1]); w.w = cvt_pk_bf16(b[2], b[3]); return w; }

struct EpiQKVA {
    static constexpr bool PERM = true, AFTER_DRAIN = false;
    bf16_t* Q; bf16_t* Kb; bf16_t* VT; const LAS float* rsl; const float* shw; const float* qg; const float* kg; const float* cs;
    __device__ __forceinline__ void operator()(const f32x4 (&acc)[2][2][4][2], const Unit& u, int wr, int wc, int fr, int fq) const {
        const int b = u.pm >> 4; const bool isk = (u.pn == 4);
        if (u.pn == 4 && wc >= 2) {
#pragma unroll
            for (int ai = 0; ai < 2; ++ai)
#pragma unroll
                for (int m = 0; m < 4; ++m) {
                    const int row = u.pm * 256 + ai * 128 + wr * 64 + m * 16 + fr; const int t = row & (SEQ - 1);
                    const float rs = rsl[((u.pm & 15) >> 2) * 256 + (row & 255)];
                    bf16_t* vrow = VT + (((size_t)(b * 2 + (wc - 2)) * 64 + (t >> 6)) * 64) * 64 + (t & 63);
#pragma unroll
                    for (int bj = 0; bj < 2; ++bj)
#pragma unroll
                        for (int n = 0; n < 2; ++n) {
                            const f32x4 bvv = *(const f32x4*)(shw + b * SHW1_LD + u.pn * 256 + bj * 128 + wc * 32 + 8 * fq + 4 * n);
                            const f32x4 v = acc[ai][bj][m][n] * rs + bvv;
                            const unsigned p01 = cvt_pk_bf16(v[0], v[1]), p23 = cvt_pk_bf16(v[2], v[3]);
                            const int d0 = 16 * fq + 8 * bj + 4 * n;
                            vrow[(size_t)(d0 + 0) * 64] = (bf16_t)(p01 & 0xffffu); vrow[(size_t)(d0 + 1) * 64] = (bf16_t)(p01 >> 16);
                            vrow[(size_t)(d0 + 2) * 64] = (bf16_t)(p23 & 0xffffu); vrow[(size_t)(d0 + 3) * 64] = (bf16_t)(p23 >> 16);
                        }
                }
            return;
        }

        const float* gain = isk ? kg : qg; const float qs = isk ? 1.0f : 0.125f;
        f32x4 bv[2][2], gv[2][2];
#pragma unroll
        for (int bj = 0; bj < 2; ++bj)
#pragma unroll
            for (int n = 0; n < 2; ++n) { bv[bj][n] = *(const f32x4*)(shw + b * SHW1_LD + u.pn * 256 + bj * 128 + wc * 32 + 8 * fq + 4 * n); gv[bj][n] = *(const f32x4*)(gain + 16 * fq + 8 * bj + 4 * n); }
#pragma unroll
        for (int ai = 0; ai < 2; ++ai)
#pragma unroll
            for (int m = 0; m < 4; ++m) {
                const int row = u.pm * 256 + ai * 128 + wr * 64 + m * 16 + fr;
                const float rs = rsl[((u.pm & 15) >> 2) * 256 + (row & 255)];
                f32x4 v[2][2]; float ss = 0.f;
#pragma unroll
                for (int bj = 0; bj < 2; ++bj)
#pragma unroll
                    for (int n = 0; n < 2; ++n) { v[bj][n] = acc[ai][bj][m][n] * rs + bv[bj][n]; const f32x4 t = v[bj][n]; ss += (t[0] * t[0] + t[1] * t[1]) + (t[2] * t[2] + t[3] * t[3]); }
                ss += __shfl_xor(ss, 16); ss += __shfl_xor(ss, 32);
                const float hr = rsqrtf(ss * (1.0f / HD) + EPS);
#pragma unroll
                for (int bj = 0; bj < 2; ++bj)
#pragma unroll
                    for (int n = 0; n < 2; ++n) v[bj][n] = v[bj][n] * hr * gv[bj][n];
                if (fq == 0) {
                    const f32x4* cp = (const f32x4*)(cs + (size_t)row * 16);
#pragma unroll
                    for (int n = 0; n < 2; ++n) { const f32x4 cc = cp[n], sn = cp[2 + n]; const f32x4 x1 = v[0][n], x2 = v[1][n]; v[0][n] = x1 * cc - x2 * sn; v[1][n] = x2 * cc + x1 * sn; }
                }
                bf16_t* dst = isk ? (Kb + (size_t)row * 128 + wc * 64) : (Q + (size_t)row * DM + (4 * u.pn + wc) * 64);
#pragma unroll
                for (int bj = 0; bj < 2; ++bj) *(u32x4*)(dst + 16 * fq + 8 * bj) = pack8(v[bj][0] * qs, v[bj][1] * qs);
            }
    }
};
struct EpiQKB {
    static constexpr bool PERM = true, AFTER_DRAIN = false;
    bf16_t* Q; bf16_t* Kb; const LAS float* rsl; const float* shw;
    __device__ __forceinline__ void operator()(const f32x4 (&acc)[2][2][4][2], const Unit& u, int wr, int wc, int fr, int fq) const {
        const int b = u.pm >> 4; const bool isk = (u.pn >= 4); const float qs = isk ? 1.0f : 0.125f * 1.4426950408889634f;
        bf16_t* base = (isk ? Kb : Q) + (u.pn & 3) * 256 + wc * 32 + 8 * fq;
        f32x4 bv[2][2];
#pragma unroll
        for (int bj = 0; bj < 2; ++bj)
#pragma unroll
            for (int n = 0; n < 2; ++n) bv[bj][n] = *(const f32x4*)(shw + b * SHW1_LD + u.pn * 256 + bj * 128 + wc * 32 + 8 * fq + 4 * n);
#pragma unroll
        for (int ai = 0; ai < 2; ++ai)
#pragma unroll
            for (int m = 0; m < 4; ++m) {
                const int row = u.pm * 256 + ai * 128 + wr * 64 + m * 16 + fr;
                const float rs = rsl[((u.pm & 15) >> 2) * 256 + (row & 255)] * qs;
#pragma unroll
                for (int bj = 0; bj < 2; ++bj) *(u32x4*)(base + (size_t)row * DM + bj * 128) = pack8(acc[ai][bj][m][0] * rs + bv[bj][0] * qs, acc[ai][bj][m][1] * rs + bv[bj][1] * qs);
            }
    }
};
template <bool MODE_A> struct EpiVT {
    static constexpr bool PERM = true, AFTER_DRAIN = false;
    bf16_t* VT; const LAS float* rsl; const float* shw;
    __device__ __forceinline__ void operator()(const f32x4 (&acc)[2][2][4][2], const Unit& u, int wr, int wc, int fr, int fq) const {
        if (MODE_A && wr == 0) return;
        const int lane = fr + 16 * fq; const int b = u.pn >> 4;
        const float myrs = rsl[((u.pn & 15) >> 2) * 256 + (lane >> 5) * 128 + wc * 32 + (lane & 31)];
        constexpr int NH = MODE_A ? 2 : 16;
#pragma unroll
        for (int bj = 0; bj < 2; ++bj) {
            float rs[8];
#pragma unroll
            for (int e = 0; e < 8; ++e) rs[e] = __shfl(myrs, bj * 32 + 8 * fq + e);
            const int t = (u.pn & 15) * 256 + bj * 128 + wc * 32 + 8 * fq;
#pragma unroll
            for (int ai = 0; ai < 2; ++ai)
#pragma unroll
                for (int m = 0; m < 4; ++m) {
                    int head, dim, bidx;
                    if (MODE_A) { const int rho = ai * 128 + wr * 64 + m * 16 + fr; head = ((rho >> 5) & 3) - 2; dim = 16 * ((rho & 31) >> 3) + 8 * ai + (rho & 7); bidx = 1024 + rho; }
                    else { const int vrow = u.pm * 256 + ai * 128 + wr * 64 + m * 16 + fr; head = vrow >> 6; dim = vrow & 63; bidx = 2048 + vrow; }
                    const float bias = shw[b * SHW1_LD + bidx];
                    const f32x4 a0 = acc[ai][bj][m][0], a1 = acc[ai][bj][m][1];
                    const f32x4 v0 = {a0[0] * rs[0] + bias, a0[1] * rs[1] + bias, a0[2] * rs[2] + bias, a0[3] * rs[3] + bias};
                    const f32x4 v1 = {a1[0] * rs[4] + bias, a1[1] * rs[5] + bias, a1[2] * rs[6] + bias, a1[3] * rs[7] + bias};
                    *(u32x4*)(VT + ((((size_t)(b * NH + head) * 64 + (t >> 6)) * 64 + dim) * 64 + (t & 63))) = pack8(v0, v1);
                }
        }
    }
};
struct EpiRes {
    static constexpr bool PERM = false, AFTER_DRAIN = false;
    const float* base; float* out; const float* gate; const float* gsn; bf16_t* xs; float* ssq; int has_next;
    __device__ __forceinline__ void operator()(const f32x4 (&acc)[2][2][4][2], const Unit& u, int wr, int wc, int fr, int fq) const {
        const int b = u.pm >> 4; const int col0 = u.pn * 256 + wc * 32 + 4 * fq;
        f32x4 gv[2][2], sv[2][2];
#pragma unroll
        for (int bj = 0; bj < 2; ++bj)
#pragma unroll
            for (int n = 0; n < 2; ++n) { gv[bj][n] = *(const f32x4*)(gate + b * NMOD + col0 + bj * 128 + n * 16); sv[bj][n] = has_next ? *(const f32x4*)(gsn + b * DM + col0 + bj * 128 + n * 16) : (f32x4){0.f, 0.f, 0.f, 0.f}; }
#pragma unroll
        for (int am = 0; am < 4; ++am) {
            const int ai = am >> 1;
            f32x4 xo[2][2][2];
#pragma unroll
            for (int mm = 0; mm < 2; ++mm) { const int m = (am & 1) * 2 + mm; const size_t off = (size_t)(u.pm * 256 + ai * 128 + wr * 64 + m * 16 + fr) * DM + col0;
#pragma unroll
                for (int bj = 0; bj < 2; ++bj)
#pragma unroll
                    for (int n = 0; n < 2; ++n) xo[mm][bj][n] = *(const f32x4*)(base + off + bj * 128 + n * 16); }
#pragma unroll
            for (int mm = 0; mm < 2; ++mm) {
                const int m = (am & 1) * 2 + mm;
                const int row = u.pm * 256 + ai * 128 + wr * 64 + m * 16 + fr; const size_t off = (size_t)row * DM + col0; float ss = 0.f;
#pragma unroll
                for (int bj = 0; bj < 2; ++bj)
#pragma unroll
                    for (int n = 0; n < 2; ++n) {
                        const f32x4 xn = xo[mm][bj][n] + gv[bj][n] * acc[ai][bj][m][n];
                        *(f32x4*)(out + off + bj * 128 + n * 16) = xn;
                        ss += (xn[0] * xn[0] + xn[1] * xn[1]) + (xn[2] * xn[2] + xn[3] * xn[3]);
                        if (has_next) { const f32x4 y = xn * sv[bj][n]; u32x2 w; w.x = cvt_pk_bf16(y[0], y[1]); w.y = cvt_pk_bf16(y[2], y[3]); *(u32x2*)(xs + off + bj * 128 + n * 16) = w; }
                    }
                ss += __shfl_xor(ss, 16); ss += __shfl_xor(ss, 32);
                if (has_next && fq == 0) ssq[(size_t)row * 16 + u.pn * 4 + wc] = ss;
            }
            asm volatile("" ::: "memory");
        }
    }
};
struct EpiSwiGLU {
    static constexpr bool PERM = true, AFTER_DRAIN = false;
    bf16_t* hid; const LAS float* rsl; const float* shw;
    __device__ __forceinline__ void operator()(const f32x4 (&acc)[2][2][4][2], const Unit& u, int wr, int wc, int fr, int fq) const {
        const int b = u.pm >> 4;
        f32x4 bg[2], bu[2];
#pragma unroll
        for (int n = 0; n < 2; ++n) { bg[n] = *(const f32x4*)(shw + b * NGU + u.pn * 256 + wc * 32 + 8 * fq + 4 * n); bu[n] = *(const f32x4*)(shw + b * NGU + u.pn * 256 + 128 + wc * 32 + 8 * fq + 4 * n); }
#pragma unroll
        for (int ai = 0; ai < 2; ++ai)
#pragma unroll
            for (int m = 0; m < 4; ++m) {
                const int row = u.pm * 256 + ai * 128 + wr * 64 + m * 16 + fr;
                const float rs = rsl[((u.pm & 15) >> 2) * 256 + (row & 255)];
                f32x4 h[2];
#pragma unroll
                for (int n = 0; n < 2; ++n) {
                    const f32x4 g = acc[ai][0][m][n] * rs + bg[n], up = acc[ai][1][m][n] * rs + bu[n];
                    f32x4 e; e[0] = __builtin_amdgcn_exp2f(-g[0]); e[1] = __builtin_amdgcn_exp2f(-g[1]); e[2] = __builtin_amdgcn_exp2f(-g[2]); e[3] = __builtin_amdgcn_exp2f(-g[3]);
                    const f32x4 d = e + 1.0f;
                    f32x4 r; r[0] = __builtin_amdgcn_rcpf(d[0]); r[1] = __builtin_amdgcn_rcpf(d[1]); r[2] = __builtin_amdgcn_rcpf(d[2]); r[3] = __builtin_amdgcn_rcpf(d[3]);
                    h[n] = (g * up) * r;
                }
                *(u32x4*)(hid + (size_t)row * DFF + u.pn * 128 + wc * 32 + 8 * fq) = pack8(h[0], h[1]);
            }
    }
};

__device__ __forceinline__ int dest_row(int kind, int n) {
    if (kind == 1) { const int hh = n >> 6, dim = n & 63; return 256 * (hh >> 2) + 128 * ((dim >> 3) & 1) + 32 * (hh & 3) + 8 * (dim >> 4) + (dim & 7); }
    if (kind == 3) return 256 * (n >> 7) + (n & 127);
    if (kind == 4) return 256 * (n >> 7) + 128 + (n & 127);
    return n;
}
__device__ __forceinline__ void transpose_item(const float* W, int K, int N, bf16_t* WT, int kind, int rowoff, LAS float* scr, int item, int lane) {
    const int nblk = N / 32, kb = item / nblk, nb = item % nblk, k0 = 64 * kb, n0 = 32 * nb;
    float tv[32];
    const float wsc = (kind == 3) ? 1.4426950408889634f : (kind == 4) ? 0.6931471805599453f : 1.0f;
#pragma unroll
    for (int i = 0; i < 32; ++i) tv[i] = W[(size_t)(k0 + 2 * i + (lane >> 5)) * N + n0 + (lane & 31)] * wsc;
#pragma unroll
    for (int i = 0; i < 32; ++i) scr[(2 * i + (lane >> 5)) * 33 + (lane & 31)] = tv[i];
    asm volatile("s_waitcnt lgkmcnt(0)" ::: "memory");
    const int c = lane & 7;
#pragma unroll
    for (int j = 0; j < 4; ++j) { const int n = (lane >> 3) + 8 * j; const LAS float* s = scr + (8 * c) * 33 + n;
        u32x4 o; o.x = cvt_pk_bf16(s[0 * 33], s[1 * 33]); o.y = cvt_pk_bf16(s[2 * 33], s[3 * 33]); o.z = cvt_pk_bf16(s[4 * 33], s[5 * 33]); o.w = cvt_pk_bf16(s[6 * 33], s[7 * 33]);
        *(u32x4*)(WT + (size_t)(dest_row(kind, n0 + n) + rowoff) * K + k0 + 8 * c) = o; }
    asm volatile("s_waitcnt lgkmcnt(0)" ::: "memory");
}

__device__ __forceinline__ void phase_p0(const Args& a, LAS unsigned char* lds, int tid, int lane, int wave) {
    unsigned char* ws = a.ws;
    { float* cs = (float*)(ws + WS_CS);
      for (int i = blockIdx.x * 512 + tid; i < NTOK * 8; i += gridDim.x * 512) {
          const int t = i >> 3, e = i & 7; const float ang = (float)a.pos[t] * INVF[e];
          const float n = rintf(ang * 0.15915494309189535f); float r = fmaf(-n, 6.2831854820251465f, ang); r = fmaf(-n, -1.7484556000744487e-07f, r);
          cs[(size_t)t * 16 + e] = __cosf(r); cs[(size_t)t * 16 + 8 + e] = __sinf(r); } }
    { LAS float* sc = (LAS float*)lds;
      LAS float* red = (LAS float*)(lds + 65536);
      for (int i = tid; i < NB * DM; i += 512) { const int b = i >> 10, k = i & 1023; const float v = a.c[i]; sc[k * 16 + b] = v / (1.0f + __expf(-v)); }
      __syncthreads();
      float* mod = (float*)(ws + WS_MOD);
      for (int item = blockIdx.x; item < DEPTH * (NMOD / 64); item += gridDim.x) {
          const int l = item / (NMOD / 64), n = (item % (NMOD / 64)) * 64 + lane;
          float acc[16];
#pragma unroll
          for (int b = 0; b < 16; ++b) acc[b] = 0.f;
          const float* wp = a.ada_w + ((size_t)l * DM + wave * 128) * NMOD + n;
#pragma unroll 16
          for (int k = 0; k < 128; ++k) { const float w = wp[(size_t)k * NMOD]; const LAS f32x4* s = (const LAS f32x4*)(sc + (wave * 128 + k) * 16);
#pragma unroll
              for (int q = 0; q < 4; ++q) { const f32x4 sv = s[q]; acc[4 * q + 0] += sv[0] * w; acc[4 * q + 1] += sv[1] * w; acc[4 * q + 2] += sv[2] * w; acc[4 * q + 3] += sv[3] * w; } }
#pragma unroll
          for (int b = 0; b < 16; ++b) red[(wave * 16 + b) * 64 + lane] = acc[b];
          __syncthreads();
          for (int o = tid; o < 16 * 64; o += 512) { const int b = o >> 6, nn = o & 63; float s = 0.f;
#pragma unroll
              for (int w = 0; w < 8; ++w) s += red[(w * 16 + b) * 64 + nn];
              const int col = (item % (NMOD / 64)) * 64 + nn; mod[((size_t)l * NB + b) * NMOD + col] = s + a.ada_b[l * NMOD + col]; }
          __syncthreads();
      } }
    __syncthreads();
    { LAS float* scr = (LAS float*)(lds + wave * 16384);
      const int gw = blockIdx.x * 8 + wave, NGW = gridDim.x * 8;
      constexpr int I_QA = 16 * 40, I_O = 16 * 32, I_QB = 16 * 96, I_G = 16 * 88, I_D = 44 * 32;
      constexpr int NIT = 2 * I_QA + 2 * I_O + 2 * I_QB + 2 * I_O + 4 * I_G + 4 * I_G + 4 * I_D;
      for (int it = gw; it < NIT; it += NGW) {
          int r = it;
          if (r < 2 * I_QA) { const int j = r / I_QA; transpose_item(a.wqkv_a + (size_t)j * DM * NQKVA, DM, NQKVA, (bf16_t*)(ws + WS_WQKVA) + (size_t)j * NQKVA * DM, 1, 0, scr, r % I_QA, lane); continue; } r -= 2 * I_QA;
          if (r < 2 * I_O) { const int j = r / I_O; transpose_item(a.wo_a + (size_t)j * DM * DM, DM, DM, (bf16_t*)(ws + WS_WOA) + (size_t)j * DM * DM, 0, 0, scr, r % I_O, lane); continue; } r -= 2 * I_O;
          if (r < 2 * I_QB) { const int j = r / I_QB, ii = r % I_QB; const bool isv = (ii % 96) >= 64;
              transpose_item(a.wqkv_b + (size_t)j * DM * NQKVB, DM, NQKVB, isv ? (bf16_t*)(ws + WS_WVB) + (size_t)j * DM * DM : (bf16_t*)(ws + WS_WQKB) + (size_t)j * 2048 * DM, 0, isv ? -2048 : 0, scr, ii, lane); continue; } r -= 2 * I_QB;
          if (r < 2 * I_O) { const int j = r / I_O; transpose_item(a.wo_b + (size_t)j * DM * DM, DM, DM, (bf16_t*)(ws + WS_WOB) + (size_t)j * DM * DM, 0, 0, scr, r % I_O, lane); continue; } r -= 2 * I_O;
          if (r < 4 * I_G) { const int l = r / I_G; transpose_item(a.w_gate + (size_t)l * DM * DFF, DM, DFF, (bf16_t*)(ws + WS_WGU) + (size_t)l * NGU * DM, 3, 0, scr, r % I_G, lane); continue; } r -= 4 * I_G;
          if (r < 4 * I_G) { const int l = r / I_G; transpose_item(a.w_up + (size_t)l * DM * DFF, DM, DFF, (bf16_t*)(ws + WS_WGU) + (size_t)l * NGU * DM, 4, 0, scr, r % I_G, lane); continue; } r -= 4 * I_G;
          { const int l = r / I_D; transpose_item(a.w_down + (size_t)l * DFF * DM, DFF, DM, (bf16_t*)(ws + WS_WD) + (size_t)l * DM * DFF, 0, 0, scr, r % I_D, lane); }
      } }
}

__device__ __forceinline__ void phase_p1(const Args& a, int tid, int lane, int wave) {
    unsigned char* ws = a.ws; const float* mod = (const float*)(ws + WS_MOD);
    { float* gs = (float*)(ws + WS_GS);
      for (int i = blockIdx.x * 512 + tid; i < DEPTH * 2 * NB * DM; i += gridDim.x * 512) {
          const int k = i & 1023, b = (i >> 10) & 15, s = (i >> 14) & 1, l = i >> 15;
          gs[i] = (s ? a.n2g : a.n1g)[l * DM + k] * (1.0f + mod[((size_t)l * NB + b) * NMOD + (s ? 4096 : 1024) + k]); } }
    const int gw = blockIdx.x * 8 + wave, NGW = gridDim.x * 8;
    { constexpr int RA = (NQKVA + NGU) / 16, RB = (NQKVB + NGU) / 16, RP = RA + RB;
      for (int r = gw; r < 2 * RP; r += NGW) {
          const int p = r / RP; int rr = r % RP; int l, n0, shoff, ld; const bf16_t* wbase; float* outp;
          if (rr < RA) { l = 2 * p;
              if (rr < NQKVA / 16) { n0 = rr * 16; wbase = (const bf16_t*)(ws + WS_WQKVA) + ((size_t)p * NQKVA + n0) * DM; shoff = 0; ld = SHW1_LD; outp = (float*)(ws + WS_SHW1) + (size_t)l * NB * SHW1_LD; }
              else { n0 = (rr - NQKVA / 16) * 16; wbase = (const bf16_t*)(ws + WS_WGU) + ((size_t)l * NGU + n0) * DM; shoff = 3072; ld = NGU; outp = (float*)(ws + WS_SHW3) + (size_t)l * NB * NGU; } }
          else { rr -= RA; l = 2 * p + 1;
              if (rr < NQKVB / 16) { n0 = rr * 16; wbase = (n0 < 2048) ? (const bf16_t*)(ws + WS_WQKB) + ((size_t)p * 2048 + n0) * DM : (const bf16_t*)(ws + WS_WVB) + ((size_t)p * DM + (n0 - 2048)) * DM; shoff = 0; ld = SHW1_LD; outp = (float*)(ws + WS_SHW1) + (size_t)l * NB * SHW1_LD; }
              else { n0 = (rr - NQKVB / 16) * 16; wbase = (const bf16_t*)(ws + WS_WGU) + ((size_t)l * NGU + n0) * DM; shoff = 3072; ld = NGU; outp = (float*)(ws + WS_SHW3) + (size_t)l * NB * NGU; } }
          const float* shp = mod + ((size_t)l * NB + (lane & 15)) * NMOD + shoff + 8 * (lane >> 4);
          const bf16_t* wp = wbase + (size_t)(lane & 15) * DM + 8 * (lane >> 4);
          f32x4 acc = {0.f, 0.f, 0.f, 0.f};
#pragma unroll 8
          for (int k0 = 0; k0 < DM; k0 += 32) {
              const bf16x8 wv = *(const bf16x8*)(wp + k0);
              const f32x4 s0 = *(const f32x4*)(shp + k0), s1 = *(const f32x4*)(shp + k0 + 4);
              u32x4 hi, lo;
              hi.x = cvt_pk_bf16(s0[0], s0[1]); hi.y = cvt_pk_bf16(s0[2], s0[3]); hi.z = cvt_pk_bf16(s1[0], s1[1]); hi.w = cvt_pk_bf16(s1[2], s1[3]);
              lo.x = cvt_pk_bf16(s0[0] - __uint_as_float(hi.x << 16), s0[1] - __uint_as_float(hi.x & 0xffff0000u)); lo.y = cvt_pk_bf16(s0[2] - __uint_as_float(hi.y << 16), s0[3] - __uint_as_float(hi.y & 0xffff0000u));
              lo.z = cvt_pk_bf16(s1[0] - __uint_as_float(hi.z << 16), s1[1] - __uint_as_float(hi.z & 0xffff0000u)); lo.w = cvt_pk_bf16(s1[2] - __uint_as_float(hi.w << 16), s1[3] - __uint_as_float(hi.w & 0xffff0000u));
              acc = __builtin_amdgcn_mfma_f32_16x16x32_bf16(__builtin_bit_cast(bf16x8, hi), wv, acc, 0, 0, 0);
              acc = __builtin_amdgcn_mfma_f32_16x16x32_bf16(__builtin_bit_cast(bf16x8, lo), wv, acc, 0, 0, 0);
          }
#pragma unroll
          for (int j = 0; j < 4; ++j) outp[(size_t)(4 * (lane >> 4) + j) * ld + n0 + (lane & 15)] = acc[j];
      } }
    { bf16_t* xs = (bf16_t*)(ws + WS_XS); float* ssq = (float*)(ws + WS_SSQ);
      for (int m0 = gw; m0 < NTOK; m0 += 2 * NGW) {
          f32x4 v[2][4];
#pragma unroll
          for (int q = 0; q < 2; ++q) { const f32x4* xr = (const f32x4*)(a.x + (size_t)(m0 + q * NGW) * DM) + lane;
#pragma unroll
              for (int j = 0; j < 4; ++j) v[q][j] = xr[64 * j]; }
#pragma unroll
          for (int q = 0; q < 2; ++q) { const int m = m0 + q * NGW; const int b = m >> 12; float s = 0.f;
#pragma unroll
              for (int j = 0; j < 4; ++j) { const f32x4 t = v[q][j]; s += (t[0] * t[0] + t[1] * t[1]) + (t[2] * t[2] + t[3] * t[3]);
                  const int col = 4 * lane + 256 * j; const f32x4 g = *(const f32x4*)(a.n1g + col), scv = *(const f32x4*)(mod + (size_t)b * NMOD + 1024 + col);
                  const f32x4 y = t * (g * (1.0f + scv)); u32x2 w; w.x = cvt_pk_bf16(y[0], y[1]); w.y = cvt_pk_bf16(y[2], y[3]); *(u32x2*)(xs + (size_t)m * DM + col) = w; }
              s = wave_sum(s); if (lane < 16) ssq[(size_t)m * 16 + lane] = (lane == 0) ? s : 0.f; } } }
}

__device__ __forceinline__ int pi32(int i) { return ((i >> 2) & 1) * 16 + (i >> 3) * 4 + (i & 3); }
#define MFMA32(a_, b_, c_) __builtin_amdgcn_mfma_f32_32x32x16_bf16((a_), (b_), (c_), 0, 0, 0)
__device__ __forceinline__ bf16x8 pack_p(const f32x16& p, int s2) {
    u32x4 w;
    if (s2 == 0) { w.x = cvt_pk_bf16(p[0], p[1]); w.y = cvt_pk_bf16(p[2], p[3]); w.z = cvt_pk_bf16(p[4], p[5]); w.w = cvt_pk_bf16(p[6], p[7]); }
    else { w.x = cvt_pk_bf16(p[8], p[9]); w.y = cvt_pk_bf16(p[10], p[11]); w.z = cvt_pk_bf16(p[12], p[13]); w.w = cvt_pk_bf16(p[14], p[15]); }
    return __builtin_bit_cast(bf16x8, w);
}
__device__ __forceinline__ void store_o(bf16_t* op, const f32x16& o0, const f32x16& o1, float sc) {
    u32x4 w;
    w.x = cvt_pk_bf16(o0[0] * sc, o0[1] * sc); w.y = cvt_pk_bf16(o0[2] * sc, o0[3] * sc); w.z = cvt_pk_bf16(o0[4] * sc, o0[5] * sc); w.w = cvt_pk_bf16(o0[6] * sc, o0[7] * sc); *(u32x4*)(op) = w;
    w.x = cvt_pk_bf16(o0[8] * sc, o0[9] * sc); w.y = cvt_pk_bf16(o0[10] * sc, o0[11] * sc); w.z = cvt_pk_bf16(o0[12] * sc, o0[13] * sc); w.w = cvt_pk_bf16(o0[14] * sc, o0[15] * sc); *(u32x4*)(op + 8) = w;
    w.x = cvt_pk_bf16(o1[0] * sc, o1[1] * sc); w.y = cvt_pk_bf16(o1[2] * sc, o1[3] * sc); w.z = cvt_pk_bf16(o1[4] * sc, o1[5] * sc); w.w = cvt_pk_bf16(o1[6] * sc, o1[7] * sc); *(u32x4*)(op + 32) = w;
    w.x = cvt_pk_bf16(o1[8] * sc, o1[9] * sc); w.y = cvt_pk_bf16(o1[10] * sc, o1[11] * sc); w.z = cvt_pk_bf16(o1[12] * sc, o1[13] * sc); w.w = cvt_pk_bf16(o1[14] * sc, o1[15] * sc); *(u32x4*)(op + 40) = w;
}
__device__ __forceinline__ int pinv32(int k) { return 8 * ((k >> 2) & 3) + 4 * (k >> 4) + (k & 3); }
constexpr int ATA_KB = 160 * 144, ATA_VB = 64 * 336, ATA_BUF = ATA_KB + ATA_VB;
__device__ __forceinline__ void attn_a_phase(const bf16_t* Q, const bf16_t* Kb, const bf16_t* VT, bf16_t* O, const float* sinks, int b, int rank, int gsz, int tid, LAS unsigned char* lds) {
    const int lane = tid & 63, wave = __builtin_amdgcn_readfirstlane(tid >> 6);
    const int ql = lane & 31, hi = lane >> 5;
    const float NEG = -__builtin_inff();
    const int ntask = 2 * 128;
    int koff[3], voff[3], krow[3], vd[3], vch[3];
#pragma unroll
    for (int r = 0; r < 3; ++r) { const int cid = tid + 512 * r; const int row = cid >> 3, c = cid & 7; krow[r] = row; koff[r] = (32 * (row >> 5) + pinv32(row & 31)) * 144 + c * 16 + ((cid & 7) * 0);
        const int d = cid / 20, ch = cid % 20; vd[r] = d; vch[r] = ch; voff[r] = ATA_KB + (32 * (d >> 5) + pinv32(d & 31)) * 336 + ch * 16; }
    const bool third = tid < 256;
    u32x4 gk[3], gv[3];
#define ATA_LOAD(TASK) do { const int blk_ = (TASK) & 127, kvh_ = (TASK) >> 7; const int ks_ = blk_ * 32 - 128; _Pragma("unroll") \
        for (int r = 0; r < 3; ++r) if (r < 2 || third) { int key_ = ks_ + krow[r]; key_ = key_ < 0 ? 0 : key_; gk[r] = *(const u32x4*)(Kb + ((size_t)b * SEQ + key_) * 128 + kvh_ * 64 + (tid & 7) * 8); \
            int kv_ = ks_ + 8 * vch[r]; kv_ = kv_ < 0 ? 0 : kv_; gv[r] = *(const u32x4*)(VT + ((((size_t)(b * 2 + kvh_) * 64 + (kv_ >> 6)) * 64 + vd[r]) * 64 + (kv_ & 63))); } } while (0)
#define ATA_STORE(BUF) do { LAS unsigned char* p_ = lds + (BUF) * ATA_BUF; _Pragma("unroll") \
        for (int r = 0; r < 3; ++r) if (r < 2 || third) { *(LAS u32x4*)(p_ + koff[r]) = gk[r]; *(LAS u32x4*)(p_ + voff[r]) = gv[r]; } } while (0)
    int it = 0;
    if (rank < ntask) { ATA_LOAD(rank); ATA_STORE(0); }
    bf16x8 qn[4];
    if (rank < ntask) { const bf16_t* qp0 = Q + ((size_t)b * SEQ + (rank & 127) * 32 + ql) * DM + ((rank >> 7) * 8 + wave) * 64 + hi * 8;
#pragma unroll
        for (int kk = 0; kk < 4; ++kk) qn[kk] = *(const bf16x8*)(qp0 + kk * 16); }
    for (int task = rank; task < ntask; task += gsz, ++it) {
        const int blk = task & 127, kvh = task >> 7, head = kvh * 8 + wave;
        const size_t row0 = (size_t)b * SEQ + blk * 32;
        bf16x8 qf[4];
#pragma unroll
        for (int kk = 0; kk < 4; ++kk) qf[kk] = qn[kk];
        const float sink = sinks[head];
        __syncthreads();
        const bool more = task + gsz < ntask;
        if (more) { ATA_LOAD(task + gsz);
            const int tn = task + gsz; const bf16_t* qpn = Q + ((size_t)b * SEQ + (tn & 127) * 32 + ql) * DM + ((tn >> 7) * 8 + wave) * 64 + hi * 8;
#pragma unroll
            for (int kk = 0; kk < 4; ++kk) qn[kk] = *(const bf16x8*)(qpn + kk * 16); }
        const LAS unsigned char* Kbuf = lds + (it & 1) * ATA_BUF; const LAS unsigned char* Vbuf = Kbuf + ATA_KB;
        f32x16 s[5];
#pragma unroll
        for (int i = 0; i < 5; ++i) {
            f32x16 z;
#pragma unroll
            for (int r = 0; r < 16; ++r) z[r] = 0.f;
#pragma unroll
            for (int kk = 0; kk < 4; ++kk) z = MFMA32(*(const LAS bf16x8*)(Kbuf + (32 * i + ql) * 144 + kk * 32 + hi * 16), qf[kk], z);
            const bool dead = (blk - 4 + i) < 0;
#pragma unroll
            for (int r = 0; r < 16; ++r) s[i][r] = dead ? NEG : z[r];
        }
#pragma unroll
        for (int r = 0; r < 16; ++r) { const int kl = 16 * hi + r; if (!(kl > ql)) s[0][r] = NEG; if (!(kl <= ql)) s[4][r] = NEG; }
        float mx = sink;
#pragma unroll
        for (int i = 0; i < 5; ++i)
#pragma unroll
            for (int r = 0; r < 16; ++r) mx = fmaxf(mx, s[i][r]);
        mx = fmaxf(mx, __shfl_xor(mx, 32));
        float den = 0.f;
#pragma unroll
        for (int i = 0; i < 5; ++i)
#pragma unroll
            for (int r = 0; r < 16; ++r) { const float p = __expf(s[i][r] - mx); s[i][r] = p; den += p; }
        den += __shfl_xor(den, 32); den += __expf(sink - mx);
        f32x16 o0, o1;
#pragma unroll
        for (int r = 0; r < 16; ++r) { o0[r] = 0.f; o1[r] = 0.f; }
#pragma unroll
        for (int i = 0; i < 5; ++i) {
            const bf16x8 pb0 = pack_p(s[i], 0), pb1 = pack_p(s[i], 1);
            const LAS unsigned char* vp = Vbuf + ql * 336 + 64 * i + 32 * hi;
            o0 = MFMA32(*(const LAS bf16x8*)(vp), pb0, o0); o0 = MFMA32(*(const LAS bf16x8*)(vp + 16), pb1, o0);
            o1 = MFMA32(*(const LAS bf16x8*)(vp + 32 * 336), pb0, o1); o1 = MFMA32(*(const LAS bf16x8*)(vp + 32 * 336 + 16), pb1, o1);
        }
        store_o(O + (row0 + ql) * DM + head * 64 + 16 * hi, o0, o1, 1.0f / den);
        if (more) ATA_STORE((it + 1) & 1);
    }
#undef ATA_LOAD
#undef ATA_STORE
    __syncthreads();
}
template <bool DIAG, int VS> __device__ __forceinline__ void sb_tile(const f32x16& z, float& carry, f32x16& o0, f32x16& o1, const LAS unsigned char* vp, int hi, int ql) {
    const bf16x8 v00 = *(const LAS bf16x8*)(vp), v01 = *(const LAS bf16x8*)(vp + 16), v10 = *(const LAS bf16x8*)(vp + 32 * VS), v11 = *(const LAS bf16x8*)(vp + 32 * VS + 16);
    f32x16 w; float run = 1.0f;
#pragma unroll
    for (int r = 15; r >= 0; --r) {
        float beta = __builtin_amdgcn_rcpf(1.0f + __builtin_amdgcn_exp2f(-z[r]));
        float om = 1.0f - beta;
        if (DIAG) { const bool valid = (16 * hi + r) < ql; beta = valid ? beta : 0.f; om = valid ? om : 1.0f; }
        w[r] = beta * run; run *= om;
    }
    const float other = __shfl_xor(run, 32);
    const float base = carry * (hi == 0 ? other : 1.0f);
    f32x16 p;
#pragma unroll
    for (int r = 0; r < 16; ++r) p[r] = w[r] * base;
    carry *= run * other;
    const bf16x8 pb0 = pack_p(p, 0), pb1 = pack_p(p, 1);
    o0 = MFMA32(v00, pb0, o0); o0 = MFMA32(v01, pb1, o0); o1 = MFMA32(v10, pb0, o1); o1 = MFMA32(v11, pb1, o1);
}
__device__ __forceinline__ void attn_b_phase(const bf16_t* Q, const bf16_t* Kb, const bf16_t* VT, bf16_t* O, int b, int gw, int NGW, int lane, LAS unsigned char* wl) {
    const int ql = lane & 31, hi = lane >> 5;
    LAS unsigned char* Kbuf = wl; LAS unsigned char* Vbuf = wl + 4608;
    const int kwoff = (lane & 7) * 16, vwoff = (lane & 3) * 16;
    const int kwbase = pinv32(lane >> 3) * 144 + kwoff, vwbase = (8 * ((lane >> 2) >> 2) + ((lane >> 2) & 3)) * 80 + vwoff;
#define KWROW(j) (kwbase + ((j) == 0 ? 0 : (j) == 1 ? 16 : (j) == 2 ? 4 : 20) * 144)
#define VWROW(j) (vwbase + ((j) == 0 ? 0 : (j) == 1 ? 4 : (j) == 2 ? 32 : 36) * 80)
    const int kroff = ql * 144 + hi * 16, vroff = ql * 80 + hi * 32;
    int it = 0;
    for (int task = gw; task < 16 * 64; task += NGW, ++it) {
        const int h = task >> 6; int jp = task & 63; if (it & 1) jp = 63 - jp;
        const int qlo = 2 * jp, qup = qlo + 1;
        const size_t row0 = (size_t)b * SEQ + qlo * 32;
        const bf16_t* qp = Q + (row0 + ql) * DM + h * 64 + hi * 8;
        bf16x8 qfl[4], qfu[4];
#pragma unroll
        for (int kk = 0; kk < 4; ++kk) { qfl[kk] = *(const bf16x8*)(qp + kk * 16); qfu[kk] = *(const bf16x8*)(qp + (size_t)32 * DM + kk * 16); }
#pragma unroll
        for (int kk = 0; kk < 4; ++kk) *(LAS bf16x8*)(wl + 9728 + kroff + kk * 32) = qfl[kk];
        const bf16_t* kg = Kb + ((size_t)b * SEQ + (lane >> 3)) * DM + h * 64 + (lane & 7) * 8;
        const bf16_t* vg = VT + ((size_t)(b * 16 + h) * 64) * 4096 + (size_t)(lane >> 2) * 64 + (lane & 3) * 8;
        f32x16 ol0, ol1, ou0, ou1;
#pragma unroll
        for (int r = 0; r < 16; ++r) { ol0[r] = 0.f; ol1[r] = 0.f; ou0[r] = 0.f; ou1[r] = 0.f; }
        float cl = 1.0f, cu = 1.0f; bool dl = false, du = false;
        u32x4 gk[4], gv[4];
        { const int key0 = qup * 32; const bf16_t* vb = vg + (size_t)(key0 >> 6) * 4096 + (key0 & 63);
#pragma unroll
          for (int j = 0; j < 4; ++j) { gk[j] = *(const u32x4*)(kg + (size_t)(key0 + 8 * j) * DM); gv[j] = *(const u32x4*)(vb + 16 * j * 64); } }
        for (int kt = qup; kt >= 0; --kt) {
#pragma unroll
            for (int j = 0; j < 4; ++j) { *(LAS u32x4*)(Kbuf + KWROW(j)) = gk[j]; *(LAS u32x4*)(Vbuf + VWROW(j)) = gv[j]; }
            if (kt > 0) { const int key0 = (kt - 1) * 32; const bf16_t* vb = vg + (size_t)(key0 >> 6) * 4096 + (key0 & 63);
#pragma unroll
                for (int j = 0; j < 4; ++j) { gk[j] = *(const u32x4*)(kg + (size_t)(key0 + 8 * j) * DM); gv[j] = *(const u32x4*)(vb + 16 * j * 64); } }
            if (!du) {
                f32x16 z;
#pragma unroll
                for (int r = 0; r < 16; ++r) z[r] = 0.f;
#pragma unroll
                for (int kk = 0; kk < 4; ++kk) z = MFMA32(*(const LAS bf16x8*)(Kbuf + kroff + kk * 32), qfu[kk], z);
                if (kt == qup) sb_tile<true, 80>(z, cu, ou0, ou1, Vbuf + vroff, hi, ql); else sb_tile<false, 80>(z, cu, ou0, ou1, Vbuf + vroff, hi, ql);
                if (__all(cu < 1e-37f)) du = true;
            }
            asm volatile("" ::: "memory");
            if (kt <= qlo && !dl) {
                f32x16 z;
#pragma unroll
                for (int r = 0; r < 16; ++r) z[r] = 0.f;
#pragma unroll
                for (int kk = 0; kk < 4; ++kk) z = MFMA32(*(const LAS bf16x8*)(Kbuf + kroff + kk * 32), *(const LAS bf16x8*)(wl + 9728 + kroff + kk * 32), z);
                if (kt == qlo) sb_tile<true, 80>(z, cl, ol0, ol1, Vbuf + vroff, hi, ql); else sb_tile<false, 80>(z, cl, ol0, ol1, Vbuf + vroff, hi, ql);
                if (__all(cl < 1e-37f)) dl = true;
            }
            if (du && dl) break;
        }
        store_o(O + (row0 + ql) * DM + h * 64 + 16 * hi, ol0, ol1, 1.0f);
        store_o(O + (row0 + 32 + ql) * DM + h * 64 + 16 * hi, ou0, ou1, 1.0f);
    }
#undef KWROW
#undef VWROW
}

__device__ __forceinline__ Args load_args() {
#if defined(__HIP_DEVICE_COMPILE__)
    const __attribute__((address_space(4))) Args* ap = (const __attribute__((address_space(4))) Args*)__builtin_amdgcn_kernarg_segment_ptr();
    asm volatile("" : "+s"(ap));
    return *ap;
#else
    return Args{};
#endif
}
struct GroupOrder {
    int nOther, b16, gsz, rank, swapped;
    __device__ __forceinline__ bool next(int i, Unit& u) const {
        int t, c;
        if (gsz == 16) {
            const int nfull = nOther >> 2, wt = nOther & 3;
            if (i < 4 * nfull) { t = 4 * (i & 3) + (rank & 3); c = 4 * (i >> 2) + (rank >> 2); }
            else { const int j = i - 4 * nfull; if (j >= wt) return false; const int h = (wt == 1) ? 16 : 8; if (wt == 3) return false; t = h * j + (rank % h); c = 4 * nfull + rank / h; if (t >= 16 || c >= nOther) return false; }
        } else { const int L = i * gsz + rank; if (L >= 16 * nOther) return false; t = L & 15; c = L >> 4; }
        t += b16; if (swapped) { u.pm = c; u.pn = t; } else { u.pm = t; u.pn = c; } return true; }
    __device__ __forceinline__ void a_ready(const Unit&) const {}
    __device__ __forceinline__ void done(const Unit&) const {}
};
__device__ __forceinline__ void counter_barrier(unsigned* cnt, unsigned target, bool same_l2) {
    asm volatile("s_waitcnt vmcnt(0) lgkmcnt(0)" ::: "memory");
    __syncthreads();
    if (threadIdx.x == 0) {
        if (!same_l2) __builtin_amdgcn_fence(__ATOMIC_RELEASE, "agent");
        asm volatile("s_waitcnt vmcnt(0)" ::: "memory");
        __hip_atomic_fetch_add(cnt, 1u, __ATOMIC_RELAXED, __HIP_MEMORY_SCOPE_AGENT);
        while (__hip_atomic_load(cnt, __ATOMIC_RELAXED, __HIP_MEMORY_SCOPE_AGENT) < target) __builtin_amdgcn_s_sleep(2);
        __builtin_amdgcn_fence(__ATOMIC_ACQUIRE, "agent");
        asm volatile("s_waitcnt vmcnt(0)" ::: "memory");
    }
    __syncthreads();
}

__global__ void __launch_bounds__(512, 2) mk_fwd(Args a0) {
    extern __shared__ __attribute__((aligned(16))) unsigned char lds_raw[];
    LAS unsigned char* lds = (LAS unsigned char*)lds_raw;
    cg::grid_group grid = cg::this_grid();
    const int wave0 = __builtin_amdgcn_readfirstlane(threadIdx.x >> 6);
    const int G = gridDim.x, GSZ = G >> 4;
    int grp, rank;
    if (G == 256) { const int xcd = blockIdx.x & 7, slot = blockIdx.x >> 3; grp = xcd * 2 + (slot >> 4); rank = slot & 15; } else { grp = blockIdx.x / GSZ; rank = blockIdx.x % GSZ; }
    int my_xcc = 0, my_ticket = 0; bool xlocal = false;
    { unsigned* ctl0 = (unsigned*)(load_args().ws + WS_CTL);
      LAS unsigned* sh = (LAS unsigned*)(lds + 136 * 1024);
      if (threadIdx.x == 0) { const unsigned x = (unsigned)__builtin_amdgcn_s_getreg((3 << 11) | 20) & 7u; sh[0] = x; sh[1] = __hip_atomic_fetch_add(ctl0 + 64 * (20 + x), 1u, __ATOMIC_RELAXED, __HIP_MEMORY_SCOPE_AGENT); }
      __syncthreads();
      my_xcc = __builtin_amdgcn_readfirstlane((int)sh[0]); my_ticket = __builtin_amdgcn_readfirstlane((int)sh[1]);
      __syncthreads(); }
    unsigned nbar = 0;
#ifdef PROBE_MASK
    unsigned long long tacc = 0ull, tprev = __builtin_amdgcn_s_memrealtime(); int prev_cls = -1;
#endif
    for (int ph = 0; ph < NPHASE; ++ph) {
        if (ph > 0) {
#ifdef PROBE_MASK
            const unsigned long long t0 = __builtin_amdgcn_s_memrealtime();
            if ((PROBE_MASK >> prev_cls) & 1) tacc += t0 - tprev;
#endif
            unsigned* ctl = (unsigned*)(load_args().ws + WS_CTL);
            if (ph == 1) { grid.sync();
                if (G == 256) { bool even = true;
#pragma unroll
                    for (int x = 0; x < 8; ++x) even = even && (__hip_atomic_load(ctl + 64 * (20 + x), __ATOMIC_RELAXED, __HIP_MEMORY_SCOPE_AGENT) == 32u);
                    if (even) { grp = my_xcc * 2 + (my_ticket >> 4); rank = my_ticket & 15; xlocal = true; } } }
            else if (ph == 2) counter_barrier(ctl, (unsigned)G, false);
            else { ++nbar; counter_barrier(ctl + 64 * (1 + grp), nbar * (unsigned)GSZ, xlocal); }
#ifdef PROBE_MASK
            unsigned long long t1 = __builtin_amdgcn_s_memrealtime();
            if (PROBE_MASK & 512) tacc += t1 - t0;
            if ((PROBE_MASK & 1024) && ph > 2) { ++nbar; counter_barrier(ctl + 64 * (1 + grp), nbar * (unsigned)GSZ, xlocal); const unsigned long long t2 = __builtin_amdgcn_s_memrealtime(); tacc += t2 - t1; t1 = t2; }
            tprev = t1;
#endif
        }
#ifdef PROBE_MASK
        if (ph == 0) prev_cls = 0; else if (ph == 1) prev_cls = 1; else { const int l_ = (ph - 2) / 5, sub_ = (ph - 2) % 5; prev_cls = (sub_ == 0) ? ((l_ & 1) ? 7 : 2) : (sub_ == 1) ? ((l_ & 1) ? 8 : 3) : (sub_ + 2); }
#endif
        int tid; asm volatile("v_mbcnt_lo_u32_b32 %0, -1, 0\n\tv_mbcnt_hi_u32_b32 %0, -1, %0" : "=v"(tid)); tid += wave0 * 64;
        const int lane = tid & 63, wave = __builtin_amdgcn_readfirstlane(tid >> 6);
        const Args a = load_args();
        unsigned char* ws = a.ws;
        bf16_t* XS = (bf16_t*)(ws + WS_XS); bf16_t* QB = (bf16_t*)(ws + WS_Q); bf16_t* KB = (bf16_t*)(ws + WS_K); bf16_t* VT = (bf16_t*)(ws + WS_VT); bf16_t* HID = (bf16_t*)(ws + WS_HID);
        float* SSQ = (float*)(ws + WS_SSQ); const float* MOD = (const float*)(ws + WS_MOD); const float* GS = (const float*)(ws + WS_GS);
        if (ph == 0) { phase_p0(a, lds, tid, lane, wave); continue; }
        if (ph == 1) { phase_p1(a, tid, lane, wave); continue; }
        const int l = (ph - 2) / 5, sub = (ph - 2) % 5, p = l >> 1; const bool isA = (l & 1) == 0;
        const float* shw1 = (const float*)(ws + WS_SHW1) + (size_t)l * NB * SHW1_LD;
        const int b16 = grp * 16;
        LAS float* rsl = (LAS float*)(lds + 131072);
        if (sub == 0 || sub == 3) {
            for (int i = tid; i < 1024; i += 512) rsl[i] = rstd_row(SSQ, (b16 + 4 * (i >> 8) + (rank & 3)) * 256 + (i & 255));
            __syncthreads();
        }
        if (sub == 0) {
            if (isA) {
                const bf16_t* W = (const bf16_t*)(ws + WS_WQKVA) + (size_t)p * NQKVA * DM;
                { pg8::Gemm g{XS, W, NTOK, NQKVA, DM}; GroupOrder S{NQKVA / 256, b16, GSZ, rank, 0};
                  EpiQKVA E{QB, KB, VT, rsl, shw1, a.qn_a + p * HD, a.kn_a + p * HD, (const float*)(ws + WS_CS)};
                  pg8::gemm_phase<EpiQKVA, GroupOrder, true, true>(lds, g, S, E, tid); }
            } else {
                { pg8::Gemm g{XS, (const bf16_t*)(ws + WS_WQKB) + (size_t)p * 2048 * DM, NTOK, 2048, DM}; GroupOrder S{8, b16, GSZ, rank, 0};
                  EpiQKB E{QB, KB, rsl, shw1};
                  pg8::gemm_phase<EpiQKB, GroupOrder, true, true>(lds, g, S, E, tid); }
                { pg8::Gemm g{(const bf16_t*)(ws + WS_WVB) + (size_t)p * DM * DM, XS, DM, NTOK, DM}; GroupOrder S{4, b16, GSZ, rank, 1};
                  EpiVT<false> E{VT, rsl, shw1};
                  pg8::gemm_phase<EpiVT<false>, GroupOrder, true, true>(lds, g, S, E, tid); }
            }
        } else if (sub == 1) {
            if (isA) attn_a_phase(QB, KB, VT, QB, a.sinks_a + p * 16, grp, rank, GSZ, tid, lds);
            else attn_b_phase(QB, KB, VT, QB, grp, rank * 8 + wave, GSZ * 8, lane, lds + wave * 16384);
        } else if (sub == 2) {
            const bf16_t* W = isA ? (const bf16_t*)(ws + WS_WOA) + (size_t)p * DM * DM : (const bf16_t*)(ws + WS_WOB) + (size_t)p * DM * DM;
            pg8::Gemm g{QB, W, NTOK, DM, DM}; GroupOrder S{4, b16, GSZ, rank, 0};
            EpiRes E{l == 0 ? a.x : a.out, a.out, MOD + (size_t)l * NB * NMOD + 2048, GS + ((size_t)l * 2 + 1) * NB * DM, XS, SSQ, 1};
            pg8::gemm_phase<EpiRes, GroupOrder, true, true>(lds, g, S, E, tid);
        } else if (sub == 3) {
            pg8::Gemm g{XS, (const bf16_t*)(ws + WS_WGU) + (size_t)l * NGU * DM, NTOK, NGU, DM}; GroupOrder S{NGU / 256, b16, GSZ, rank, 0};
            EpiSwiGLU E{HID, rsl, (const float*)(ws + WS_SHW3) + (size_t)l * NB * NGU};
            pg8::gemm_phase<EpiSwiGLU, GroupOrder, true, true>(lds, g, S, E, tid);
        } else {
            pg8::Gemm g{HID, (const bf16_t*)(ws + WS_WD) + (size_t)l * DM * DFF, NTOK, DM, DFF}; GroupOrder S{4, b16, GSZ, rank, 0};
            EpiRes E{a.out, a.out, MOD + (size_t)l * NB * NMOD + 5120, GS + ((size_t)(l + 1) * 2) * NB * DM, XS, SSQ, l < DEPTH - 1 ? 1 : 0};
            pg8::gemm_phase<EpiRes, GroupOrder, true, true>(lds, g, S, E, tid);
        }
    }
#ifdef PROBE_MASK
    { const unsigned long long t0 = __builtin_amdgcn_s_memrealtime();
      if ((PROBE_MASK >> prev_cls) & 1) tacc += t0 - tprev;
      if (blockIdx.x == 0) { while (__builtin_amdgcn_s_memrealtime() - t0 < tacc) __builtin_amdgcn_s_sleep(8); } }
#endif
}

extern "C" void kernel_launch(void* const* d_in, const int* in_sizes, int n_in, void* d_out, int out_size, void* d_ws, size_t ws_size, hipStream_t stream) {
    static int grid = 0;
    if (grid == 0) {
        if (n_in != 17 || in_sizes[0] != NTOK * DM || out_size != NTOK * DM || ws_size < WS_END) { fprintf(stderr, "kernel_launch: unexpected shapes / workspace (n_in %d, ws %zu, need %zu)\n", n_in, ws_size, (size_t)WS_END); grid = -1; return; }
        int dev = 0, cus = 0, per_cu = 0;
        (void)hipGetDevice(&dev); (void)hipDeviceGetAttribute(&cus, hipDeviceAttributeMultiprocessorCount, dev);
        if (hipFuncSetAttribute((const void*)mk_fwd, hipFuncAttributeMaxDynamicSharedMemorySize, LDS_BYTES) != hipSuccess) { fprintf(stderr, "kernel_launch: hipFuncSetAttribute failed\n"); grid = -1; return; }
        if (hipOccupancyMaxActiveBlocksPerMultiprocessor(&per_cu, (const void*)mk_fwd, 512, LDS_BYTES) != hipSuccess || per_cu < 1) { fprintf(stderr, "kernel_launch: occupancy query says %d\n", per_cu); }
        (void)hipGetLastError();
        grid = 256;
        if (cus < 256) { fprintf(stderr, "kernel_launch: %d CUs, this kernel needs 256 co-resident workgroups\n", cus); grid = -1; return; }
    }
    if (grid < 0) return;
    if (hipMemsetAsync((char*)d_ws + WS_CTL, 0, CTL_BYTES, stream) != hipSuccess) { fprintf(stderr, "kernel_launch: memset failed\n"); return; }
    Args a{};
    a.x = (const float*)d_in[0]; a.c = (const float*)d_in[1]; a.pos = (const int*)d_in[2]; a.ada_w = (const float*)d_in[3]; a.ada_b = (const float*)d_in[4];
    a.n1g = (const float*)d_in[5]; a.n2g = (const float*)d_in[6]; a.wqkv_a = (const float*)d_in[7]; a.qn_a = (const float*)d_in[8]; a.kn_a = (const float*)d_in[9];
    a.sinks_a = (const float*)d_in[10]; a.wo_a = (const float*)d_in[11]; a.wqkv_b = (const float*)d_in[12]; a.wo_b = (const float*)d_in[13];
    a.w_gate = (const float*)d_in[14]; a.w_up = (const float*)d_in[15]; a.w_down = (const float*)d_in[16];
    a.out = (float*)d_out; a.ws = (unsigned char*)d_ws; a.ph_lo = 0; a.ph_hi = NPHASE;
    void* args[] = {&a};
    hipError_t e = hipLaunchCooperativeKernel((const void*)mk_fwd, dim3(grid), dim3(512), args, LDS_BYTES, stream);
    if (e != hipSuccess) fprintf(stderr, "kernel_launch: cooperative launch failed: %s (grid %d)\n", hipGetErrorString(e), grid);
}
```
